# Optimizing an MI355X kernel written in HIP

```python
import jax, jax.numpy as jnp
from jax import lax
import numpy as np

D_MODEL = 1024
BATCH = 2
SEQ = 8192
DEPTH = 1

EPS = 1e-6
CONV_WIDTH = D_MODEL
CONV_K = 3
GDN_HEADS = 8
GDN_DK = 128
GDN_DV = 128
GDN_CONV_K = 4
GDN_CHUNK = 64
GDN_QK = GDN_HEADS * GDN_DK
GDN_VW = GDN_HEADS * GDN_DV
D_FF = 256 * ((8 * D_MODEL // 3 + 255) // 256)
FFN_CONV_K = 3
IN_SPLITS = (CONV_WIDTH, CONV_WIDTH, CONV_WIDTH, GDN_QK, GDN_QK, GDN_VW, GDN_VW, GDN_HEADS, GDN_HEADS, D_MODEL, D_MODEL)
IN_WIDTH = sum(IN_SPLITS)

kernel_name = "hybrid_shortconv_gdn_gated_merge_convffn"


def _split_points():
    pts, acc = [], 0
    for w in IN_SPLITS[:-1]:
        acc += w
        pts.append(acc)
    return pts


def rmsnorm(x, g):
    xf = x.astype(jnp.float32)
    y = xf * lax.rsqrt(jnp.mean(xf * xf, axis=-1, keepdims=True) + EPS)
    return (y * g.astype(jnp.float32)).astype(x.dtype)


def l2norm(x):
    return x * lax.rsqrt(jnp.sum(x * x, axis=-1, keepdims=True) + EPS)


def causal_dwconv(x, w):
    K = w.shape[0]
    S = x.shape[1]
    xp = jnp.pad(x, ((0, 0), (K - 1, 0), (0, 0)))
    return sum(xp[:, j:j + S] * w[j] for j in range(K))


def short_conv_branch(bg, cg, xv, conv_w):
    return bg * causal_dwconv(cg * xv, conv_w)


def gated_delta_rule_chunked(q, k, v, g, beta):
    Bsz, S, H, dk = q.shape
    dv = v.shape[-1]
    C = GDN_CHUNK
    N = S // C

    def chunks(t):
        return t.reshape(Bsz, N, C, H, *t.shape[3:]).swapaxes(2, 3)

    q, k, v, g, beta = (chunks(t) for t in (q, k, v, g, beta))
    G = jnp.cumsum(g, axis=-1)
    tril = jnp.tril(jnp.ones((C, C), dtype=bool))
    strict = jnp.tril(jnp.ones((C, C), dtype=bool), -1)
    decay = jnp.exp(jnp.where(tril, G[..., :, None] - G[..., None, :], -jnp.inf))
    k_beta = k * beta[..., None]
    v_beta = v * beta[..., None]
    L = jnp.where(strict, jnp.einsum('bnhid,bnhjd->bnhij', k_beta, k) * decay, 0.0)
    eye = jnp.eye(C, dtype=q.dtype)
    rhs = jnp.concatenate([v_beta, k_beta * jnp.exp(G)[..., None]], axis=-1)
    sol = lax.linalg.triangular_solve(eye + L, rhs, left_side=True, lower=True)
    u, w = sol[..., :dv], sol[..., dv:]
    A_qk = jnp.einsum('bnhid,bnhjd->bnhij', q, k) * decay
    q_dec = q * jnp.exp(G)[..., None]
    G_last = G[..., -1:]
    k_dec = k * jnp.exp(G_last - G)[..., None]

    def step(state, inp):
        q_c, k_c, u_c, w_c, A_c, gl = inp
        v_new = u_c - jnp.einsum('bhcd,bhde->bhce', w_c, state)
        o = jnp.einsum('bhcd,bhde->bhce', q_c, state) + jnp.einsum('bhij,bhje->bhie', A_c, v_new)
        state = state * jnp.exp(gl)[..., None] + jnp.einsum('bhcd,bhce->bhde', k_c, v_new)
        return state, o

    xs = tuple(jnp.moveaxis(t, 1, 0) for t in (q_dec, k_dec, u, w, A_qk, G_last))
    state0 = jnp.zeros((Bsz, H, dk, dv), dtype=q.dtype)
    _, o = lax.scan(step, state0, xs)
    return o.transpose(1, 0, 3, 2, 4).reshape(Bsz, S, H, dv)


def gdn_branch(q, k, v, z, a, b, conv_w, A_log, dt_bias, norm_g):
    Bsz, S, _ = q.shape
    dtype = q.dtype
    f32 = jnp.float32
    qkv = jax.nn.silu(causal_dwconv(jnp.concatenate([q, k, v], axis=-1), conv_w))
    q, k, v = jnp.split(qkv, [GDN_QK, 2 * GDN_QK], axis=-1)
    q = l2norm(q.reshape(Bsz, S, GDN_HEADS, GDN_DK).astype(f32)) * (GDN_DK ** -0.5)
    k = l2norm(k.reshape(Bsz, S, GDN_HEADS, GDN_DK).astype(f32))
    v = v.reshape(Bsz, S, GDN_HEADS, GDN_DV).astype(f32)
    beta = jax.nn.sigmoid(b.astype(f32))
    g = -jnp.exp(A_log.astype(f32)) * jax.nn.softplus(a.astype(f32) + dt_bias.astype(f32))
    o = gated_delta_rule_chunked(q, k, v, g, beta)
    o = o * lax.rsqrt(jnp.mean(o * o, axis=-1, keepdims=True) + EPS) * norm_g.astype(f32)
    o = o * jax.nn.silu(z.reshape(Bsz, S, GDN_HEADS, GDN_DV).astype(f32))
    return o.reshape(Bsz, S, GDN_VW).astype(dtype)


def conv_ffn(h, w_up, conv_w, w_down):
    up = causal_dwconv(h @ w_up, conv_w)
    gate, val = jnp.split(up, [D_FF], axis=-1)
    return (jax.nn.silu(gate) * val) @ w_down


def setup_inputs(seed: int = 0) -> dict:
    key = jax.random.key(seed)
    ks = jax.random.split(key, 16)
    f32 = jnp.float32
    nrm = lambda k, shape, scale: jax.random.normal(k, shape, f32) * scale
    x = jax.random.normal(ks[0], (BATCH, SEQ, D_MODEL), f32)
    norm_mix_g = 1.0 + nrm(ks[1], (DEPTH, D_MODEL), 0.02)
    w_in = nrm(ks[2], (DEPTH, D_MODEL, IN_WIDTH), D_MODEL ** -0.5)
    conv_a_w = nrm(ks[3], (DEPTH, CONV_K, CONV_WIDTH), CONV_K ** -0.5)
    gdn_conv_w = nrm(ks[4], (DEPTH, GDN_CONV_K, 2 * GDN_QK + GDN_VW), GDN_CONV_K ** -0.5)
    gdn_A_log = jnp.log(jax.random.uniform(ks[5], (DEPTH, GDN_HEADS), f32, 1.0, 16.0))
    dt = jnp.exp(jax.random.uniform(ks[6], (DEPTH, GDN_HEADS), f32, np.log(1e-3), np.log(1e-1)))
    gdn_dt_bias = dt + jnp.log(-jnp.expm1(-dt))
    gdn_norm_g = 1.0 + nrm(ks[7], (DEPTH, GDN_DV), 0.02)
    w_a_out = nrm(ks[8], (DEPTH, CONV_WIDTH, D_MODEL), CONV_WIDTH ** -0.5)
    w_b_out = nrm(ks[9], (DEPTH, GDN_VW, D_MODEL), GDN_VW ** -0.5)
    w_o = nrm(ks[10], (DEPTH, D_MODEL, D_MODEL), D_MODEL ** -0.5)
    norm_ffn_g = 1.0 + nrm(ks[11], (DEPTH, D_MODEL), 0.02)
    w_up = nrm(ks[12], (DEPTH, D_MODEL, 2 * D_FF), D_MODEL ** -0.5)
    ffn_conv_w = nrm(ks[13], (DEPTH, FFN_CONV_K, 2 * D_FF), FFN_CONV_K ** -0.5)
    w_down = nrm(ks[14], (DEPTH, D_FF, D_MODEL), D_FF ** -0.5)
    norm_final_g = 1.0 + nrm(ks[15], (D_MODEL,), 0.02)
    return {"x": x, "norm_mix_g": norm_mix_g, "w_in": w_in, "conv_a_w": conv_a_w,
            "gdn_conv_w": gdn_conv_w, "gdn_A_log": gdn_A_log, "gdn_dt_bias": gdn_dt_bias,
            "gdn_norm_g": gdn_norm_g, "w_a_out": w_a_out, "w_b_out": w_b_out, "w_o": w_o,
            "norm_ffn_g": norm_ffn_g, "w_up": w_up, "ffn_conv_w": ffn_conv_w, "w_down": w_down,
            "norm_final_g": norm_final_g}


def reference(x, norm_mix_g, w_in, conv_a_w, gdn_conv_w, gdn_A_log, gdn_dt_bias, gdn_norm_g,
              w_a_out, w_b_out, w_o, norm_ffn_g, w_up, ffn_conv_w, w_down, norm_final_g):
    pts = _split_points()
    for l in range(DEPTH):
        h = rmsnorm(x, norm_mix_g[l])
        proj = h @ w_in[l]
        bg, cg, xv, q, k, v, z, a, b, ga, gb = jnp.split(proj, pts, axis=-1)
        y_a = short_conv_branch(bg, cg, xv, conv_a_w[l]) @ w_a_out[l]
        y_b = gdn_branch(q, k, v, z, a, b, gdn_conv_w[l], gdn_A_log[l], gdn_dt_bias[l],
                         gdn_norm_g[l]) @ w_b_out[l]
        mix = jax.nn.sigmoid(ga) * y_a + jax.nn.sigmoid(gb) * y_b
        x = x + mix @ w_o[l]
        h = rmsnorm(x, norm_ffn_g[l])
        x = x + conv_ffn(h, w_up[l], ffn_conv_w[l], w_down[l])
    return rmsnorm(x, norm_final_g)
```

```cpp
#include <hip/hip_runtime.h>
#include <hip/hip_cooperative_groups.h>
#include <cstdio>
#include <cstdint>
namespace cg = cooperative_groups;
namespace pg8 {
#define PG8_LAS __attribute__((address_space(3)))
typedef unsigned short bf16_t;
typedef short bf16x8 __attribute__((ext_vector_type(8)));
typedef float f32x4 __attribute__((ext_vector_type(4)));
typedef unsigned u32x4 __attribute__((ext_vector_type(4)));
constexpr int BM = 256, BK = 64, HALF = 128, HTB = HALF * BK * 2  , STAGE_BYTES = 8 * HTB, NXCD = 8, WGM = 8;

__host__ __device__ __forceinline__ int lds_byte(int r, int c) { const int st = (r >> 4) * 2 + (c >> 5), rr = r & 15, cc = c & 31, ob = rr * 64 + cc * 2; return st * 1024 + (ob ^ (((ob >> 9) & 1) << 5)); }
__host__ __device__ __forceinline__ void stage_rc(int b, int& R, int& C) { const int st = b / 1024, sb = b % 1024, swz = sb ^ (((sb >> 9) & 1) << 5); R = (st >> 1) * 16 + swz / 64; C = (st & 1) * 32 + (swz % 64) / 2; }
__host__ __device__ __forceinline__ int perm32(int rho) { const int n = rho >> 4, i = rho & 15; return 8 * (i >> 2) + 4 * n + (i & 3); }

struct Unit { int pm, pn; };
struct Gemm { const bf16_t* A; const bf16_t* Bt; int M, N, K; };

struct StaticOrder {
    int nM, nN, nwg, G, c;
    __host__ __device__ __forceinline__ void init(int M, int N, int G_, int c_) { nM = M / BM; nN = N / BM; nwg = nM * nN; G = G_; c = c_; }
    __host__ __device__ __forceinline__ bool next(int i, Unit& u) const {
        const long L = (long)i * G + c; if (L >= nwg) return false;
        int wgid = (int)L; { const int q = nwg / NXCD, r = nwg % NXCD, xcd = wgid % NXCD, off = wgid / NXCD; wgid = (xcd < r ? xcd * (q + 1) : r * (q + 1) + (xcd - r) * q) + off; }
        const int nig = WGM * nN, gid = wgid / nig, fm = gid * WGM, gsz = (nM - fm) < WGM ? (nM - fm) : WGM;
        u.pm = fm + ((wgid % nig) % gsz); u.pn = (wgid % nig) / gsz; return true;
    }
    __device__ __forceinline__ void a_ready(const Unit&) const {}
    __device__ __forceinline__ void done(const Unit&) const {}
};

__device__ __forceinline__ unsigned cvt_pk_bf16(float lo, float hi) { unsigned r; asm volatile("v_cvt_pk_bf16_f32 %0, %1, %2" : "=v"(r) : "v"(lo), "v"(hi)); return r; }
__device__ __forceinline__ void settle(f32x4& a) { asm volatile("s_nop 15\n\ts_nop 3" : "+v"(a)); }
__device__ __forceinline__ float bflo(unsigned u) { return __uint_as_float(u << 16); }
__device__ __forceinline__ float bfhi(unsigned u) { return __uint_as_float(u & 0xffff0000u); }
__device__ __forceinline__ float sigm(float x) { return 1.0f / (1.0f + __expf(-x)); }
struct EpiB {
    static constexpr bool PERM = true, AFTER_DRAIN = false;
    bf16_t* O; int ldc; int split_cols; size_t split_stride; int mode; const bf16_t* G1; const bf16_t* Y;
    __device__ __forceinline__ void operator()(const f32x4 (&acc)[2][2][4][2], const Unit& u, int wr, int wc, int fr, int fq) const {
        const int row0 = u.pm * BM + wr * 64 + fr; int colt = u.pn * BM; bf16_t* base = O;
        if (split_cols) { const int t = colt / split_cols; base += (size_t)t * split_stride; colt -= t * split_cols; }
        const int col0 = colt + wc * 32 + 8 * fq;
        asm volatile("s_nop 15\n\ts_nop 3" ::: "memory");
#pragma unroll
        for (int ai = 0; ai < 2; ++ai)
#pragma unroll
            for (int m = 0; m < 4; ++m) { const size_t roff = (size_t)(row0 + ai * HALF + m * 16) * ldc + col0;
#pragma unroll
                for (int bj = 0; bj < 2; ++bj) { f32x4 v0 = acc[ai][bj][m][0], v1 = acc[ai][bj][m][1];
                    if (mode) { const u32x4 gv = *(const u32x4*)(G1 + roff + bj * HALF);
                        v0[0] *= sigm(bflo(gv.x)); v0[1] *= sigm(bfhi(gv.x)); v0[2] *= sigm(bflo(gv.y)); v0[3] *= sigm(bfhi(gv.y));
                        v1[0] *= sigm(bflo(gv.z)); v1[1] *= sigm(bfhi(gv.z)); v1[2] *= sigm(bflo(gv.w)); v1[3] *= sigm(bfhi(gv.w));
                        if (mode == 2) { const u32x4 yv = *(const u32x4*)(Y + roff + bj * HALF);
                            v0[0] += bflo(yv.x); v0[1] += bfhi(yv.x); v0[2] += bflo(yv.y); v0[3] += bfhi(yv.y);
                            v1[0] += bflo(yv.z); v1[1] += bfhi(yv.z); v1[2] += bflo(yv.w); v1[3] += bfhi(yv.w); } }
                    u32x4 w; w.x = cvt_pk_bf16(v0[0], v0[1]); w.y = cvt_pk_bf16(v0[2], v0[3]); w.z = cvt_pk_bf16(v1[0], v1[1]); w.w = cvt_pk_bf16(v1[2], v1[3]);
                    *(u32x4*)(base + roff + bj * HALF) = w; } }
    }
};
struct EpiF {
    static constexpr bool PERM = false, AFTER_DRAIN = false;
    const float* base; float* out; int ldc;
    __device__ __forceinline__ void operator()(const f32x4 (&acc)[2][2][4][2], const Unit& u, int wr, int wc, int fr, int fq) const {
        const int row0 = u.pm * BM + wr * 64 + fr, col0 = u.pn * BM + wc * 32 + 4 * fq;
#pragma unroll
        for (int ai = 0; ai < 2; ++ai)
#pragma unroll
            for (int m = 0; m < 4; ++m) { const size_t off = (size_t)(row0 + ai * HALF + m * 16) * ldc + col0;
#pragma unroll
                for (int bj = 0; bj < 2; ++bj)
#pragma unroll
                    for (int n = 0; n < 2; ++n) { const f32x4 bs = *(const f32x4*)(base + off + bj * HALF + n * 16); *(f32x4*)(out + off + bj * HALF + n * 16) = bs + acc[ai][bj][m][n]; } }
    }
};

typedef unsigned u32x2 __attribute__((ext_vector_type(2)));
struct EpiF2 {
    static constexpr bool PERM = false, AFTER_DRAIN = false;
    const float* base; float* out; bf16_t* ob; float* ssqp; int ldc;
    __device__ __forceinline__ void operator()(const f32x4 (&acc)[2][2][4][2], const Unit& u, int wr, int wc, int fr, int fq) const {
        const int row0 = u.pm * BM + wr * 64 + fr, col0 = u.pn * BM + wc * 32 + 4 * fq;
#pragma unroll
        for (int ai = 0; ai < 2; ++ai)
#pragma unroll
            for (int m = 0; m < 4; ++m) { const int row = row0 + ai * HALF + m * 16; const size_t off = (size_t)row * ldc + col0; float ss = 0.f;
#pragma unroll
                for (int bj = 0; bj < 2; ++bj)
#pragma unroll
                    for (int n = 0; n < 2; ++n) { const f32x4 bs = *(const f32x4*)(base + off + bj * HALF + n * 16); const f32x4 v = bs + acc[ai][bj][m][n];
                        *(f32x4*)(out + off + bj * HALF + n * 16) = v; ss += (v[0] * v[0] + v[1] * v[1]) + (v[2] * v[2] + v[3] * v[3]);
                        u32x2 w; w.x = cvt_pk_bf16(v[0], v[1]); w.y = cvt_pk_bf16(v[2], v[3]); *(u32x2*)(ob + off + bj * HALF + n * 16) = w; }
                ss += __shfl_xor(ss, 16); ss += __shfl_xor(ss, 32);
                if (fq == 0) ssqp[(size_t)row * 16 + u.pn * 4 + wc] = ss; }
    }
};
struct EpiAct {
    static constexpr bool PERM = true, AFTER_DRAIN = true;
    bf16_t* act; const float* cw; const float* ssqp; int pm, pn, Mrows, seq_mask, ff;
    __device__ __forceinline__ void fused(f32x4 (&acc)[2][2][4][2], const Unit& u, int wr, int wc, int fr, int fq, PG8_LAS unsigned char* lds, int wid, int lane) const {
        asm volatile("s_nop 15\n\ts_nop 3" ::: "memory");
#pragma unroll
        for (int ai = 0; ai < 2; ++ai)
#pragma unroll
            for (int m = 0; m < 4; ++m) { const int row = ai * HALF + wr * 64 + m * 16 + fr, g = 254 * pm - 2 + row; float rs = 1.f;
                if (ssqp != nullptr && g >= 0 && g < Mrows) { const f32x4* sp = (const f32x4*)(ssqp + (size_t)g * 16); const f32x4 s0 = sp[0], s1 = sp[1], s2 = sp[2], s3 = sp[3];
                    rs = rsqrtf((((s0[0] + s0[1]) + (s0[2] + s0[3])) + ((s1[0] + s1[1]) + (s1[2] + s1[3])) + ((s2[0] + s2[1]) + (s2[2] + s2[3])) + ((s3[0] + s3[1]) + (s3[2] + s3[3]))) * (1.0f / 1024.0f) + 1e-6f); }
#ifdef DBG_RS
                rs = 0.7f;
#endif
#pragma unroll
                for (int bj = 0; bj < 2; ++bj) { const f32x4 v0 = acc[ai][bj][m][0] * rs, v1 = acc[ai][bj][m][1] * rs;
                    u32x4 w; w.x = cvt_pk_bf16(v0[0], v0[1]); w.y = cvt_pk_bf16(v0[2], v0[3]); w.z = cvt_pk_bf16(v1[0], v1[1]); w.w = cvt_pk_bf16(v1[2], v1[3]);
                    *(PG8_LAS u32x4*)(lds + row * 528 + (bj * HALF + wc * 32 + 8 * fq) * 2) = w; } }
        asm volatile("s_waitcnt lgkmcnt(0)" ::: "memory"); __builtin_amdgcn_s_barrier(); asm volatile("" ::: "memory");
        const int t = wid * 64 + lane, cg8 = t & 15, lr0 = (t >> 4) * 8;
        u32x4 a[10], b[10];
#pragma unroll
        for (int i = 0; i < 10; ++i) { if (lr0 + i < 256) { a[i] = *(const PG8_LAS u32x4*)(lds + (lr0 + i) * 528 + cg8 * 16); b[i] = *(const PG8_LAS u32x4*)(lds + (lr0 + i) * 528 + 256 + cg8 * 16); } else { a[i] = (u32x4){0u, 0u, 0u, 0u}; b[i] = a[i]; } }
        const int col = pn * HALF + 8 * cg8;
        f32x4 wg[3][2], wv[3][2];
#pragma unroll
        for (int j = 0; j < 3; ++j) { wg[j][0] = *(const f32x4*)(cw + j * 2 * ff + col); wg[j][1] = *(const f32x4*)(cw + j * 2 * ff + col + 4); wv[j][0] = *(const f32x4*)(cw + j * 2 * ff + ff + col); wv[j][1] = *(const f32x4*)(cw + j * 2 * ff + ff + col + 4); }
#pragma unroll
        for (int i = 0; i < 8; ++i) {
            const int lr = lr0 + 2 + i, g = 254 * pm - 2 + lr, tb = g & seq_mask;
            if (lr < 256 && g < Mrows) {
                const float m1 = (tb >= 1) ? 1.f : 0.f, m0 = (tb >= 2) ? 1.f : 0.f;
                float o[8];
#pragma unroll
                for (int k = 0; k < 8; ++k) {
                    const unsigned a0 = a[i][k >> 1], a1 = a[i + 1][k >> 1], a2 = a[i + 2][k >> 1];
                    const unsigned b0 = b[i][k >> 1], b1 = b[i + 1][k >> 1], b2 = b[i + 2][k >> 1];
                    const float ga0 = (k & 1) ? bfhi(a0) : bflo(a0), ga1 = (k & 1) ? bfhi(a1) : bflo(a1), ga2 = (k & 1) ? bfhi(a2) : bflo(a2);
                    const float va0 = (k & 1) ? bfhi(b0) : bflo(b0), va1 = (k & 1) ? bfhi(b1) : bflo(b1), va2 = (k & 1) ? bfhi(b2) : bflo(b2);
                    const float ag = (tb >= 2 ? wg[0][k >> 2][k & 3] * ga0 : 0.f) + (tb >= 1 ? wg[1][k >> 2][k & 3] * ga1 : 0.f) + wg[2][k >> 2][k & 3] * ga2;
                    const float av = (tb >= 2 ? wv[0][k >> 2][k & 3] * va0 : 0.f) + (tb >= 1 ? wv[1][k >> 2][k & 3] * va1 : 0.f) + wv[2][k >> 2][k & 3] * va2;
                    o[k] = ag / (1.0f + __expf(-ag)) * av; }
                (void)m1; (void)m0;
                u32x4 ww; ww.x = cvt_pk_bf16(o[0], o[1]); ww.y = cvt_pk_bf16(o[2], o[3]); ww.z = cvt_pk_bf16(o[4], o[5]); ww.w = cvt_pk_bf16(o[6], o[7]);
                *(u32x4*)(act + (size_t)g * ff + col) = ww;
            }
        }
        asm volatile("s_waitcnt lgkmcnt(0)" ::: "memory"); __builtin_amdgcn_s_barrier(); asm volatile("" ::: "memory");
    }
};
struct OneUnit {
    Unit u;
    __device__ __forceinline__ bool next(int i, Unit& o) const { if (i) return false; o = u; return true; }
    __device__ __forceinline__ void a_ready(const Unit&) const {}
    __device__ __forceinline__ void done(const Unit&) const {}
};

template <class Epi, class Sched, bool ALIGN_EPI = false, bool SP2 = false>
__device__ __forceinline__ void gemm_phase(PG8_LAS unsigned char* lds, const Gemm g, const Sched& S, const Epi& E) {
    int tid = threadIdx.x; asm volatile("" : "+v"(tid)); const int wid = __builtin_amdgcn_readfirstlane(tid >> 6), lane = tid & 63, wr = wid >> 2, wc = wid & 3, fr = lane & 15, fq = lane >> 4;
    const int K = g.K, nt = K / BK;
    unsigned voffA[2], voffB[2];
#pragma unroll
    for (int i = 0; i < 2; ++i) { int R, C; stage_rc(tid * 16 + i * 8192, R, C); const int Rb = Epi::PERM ? ((R & ~31) + perm32(R & 31)) : R;
        voffA[i] = (unsigned)(R * K + C) * 2u; voffB[i] = (unsigned)(Rb * K + C) * 2u; }
    const size_t kstep = (size_t)(BK * 2);
    const size_t hstep = (size_t)HALF * K * 2;
    const size_t tstep = 2 * hstep;
    const unsigned ldsw = (unsigned)wid * 1024u;
    const int aoff = lds_byte(wr * 64 + fr, fq * 8), boff = lds_byte(wc * 32 + fr, fq * 8);
#define PG8_SA(b, h) (((b) * 2 + (h)) * HTB)
#define PG8_SB(b, h) ((4 + (b) * 2 + (h)) * HTB)
#define PG8_STAGE(bufoff, gbase, voff) do { _Pragma("unroll") for (int _i = 0; _i < 2; ++_i) \
        __builtin_amdgcn_global_load_lds((const unsigned*)((const char*)(gbase) + (voff)[_i]), (PG8_LAS unsigned*)(lds + (bufoff) + ldsw + _i * 8192), 16, 0, 0); } while (0)
#define PG8_LDA(dst, b, h) do { _Pragma("unroll") for (int m = 0; m < 4; ++m) _Pragma("unroll") for (int k = 0; k < 2; ++k) dst[m][k] = *(const PG8_LAS bf16x8*)(lds + PG8_SA(b, h) + aoff + m * 2048 + k * 1024); } while (0)
#define PG8_LDB(dst, b, h) do { _Pragma("unroll") for (int n = 0; n < 2; ++n) _Pragma("unroll") for (int k = 0; k < 2; ++k) dst[n][k] = *(const PG8_LAS bf16x8*)(lds + PG8_SB(b, h) + boff + n * 2048 + k * 1024); } while (0)
#define PG8_MMA(ai, bj, At, Bt) do { __builtin_amdgcn_s_setprio(1); _Pragma("unroll") for (int m = 0; m < 4; ++m) _Pragma("unroll") for (int n = 0; n < 2; ++n) _Pragma("unroll") for (int k = 0; k < 2; ++k) \
        acc[ai][bj][m][n] = __builtin_amdgcn_mfma_f32_16x16x32_bf16(Bt[n][k], At[m][k], acc[ai][bj][m][n], 0, 0, 0); __builtin_amdgcn_s_setprio(0); } while (0)
#define PG8_WAIT_V(n) asm volatile("s_waitcnt vmcnt(" #n ")" ::: "memory")
#define PG8_WAIT_L(n) asm volatile("s_waitcnt lgkmcnt(" #n ")" ::: "memory")
#define PG8_BAR __builtin_amdgcn_s_barrier()
#define PG8_SCHED __builtin_amdgcn_sched_barrier(0)
    Unit cur, nxt; int ui = 0;
    if (!S.next(0, cur)) return;
    f32x4 acc[2][2][4][2];
#pragma unroll
    for (int a = 0; a < 2; ++a)
#pragma unroll
        for (int b = 0; b < 2; ++b)
#pragma unroll
            for (int m = 0; m < 4; ++m)
#pragma unroll
                for (int n = 0; n < 2; ++n) acc[a][b][m][n] = (f32x4){0.f, 0.f, 0.f, 0.f};
    bf16x8 At[4][2], B0[2][2], B1[2][2];
    const char* cA = (const char*)g.A + (size_t)cur.pm * tstep; const char* cB = (const char*)g.Bt + (size_t)cur.pn * tstep;
    S.a_ready(cur);
    if constexpr (SP2) {
        PG8_STAGE(PG8_SB(0, 0), cB, voffB); PG8_STAGE(PG8_SB(0, 1), cB + hstep, voffB); PG8_STAGE(PG8_SA(0, 0), cA, voffA); PG8_STAGE(PG8_SA(0, 1), cA + hstep, voffA);
        if (wr == 1) PG8_BAR;
        PG8_WAIT_V(2); PG8_BAR;
        PG8_STAGE(PG8_SB(1, 0), cB + kstep, voffB); PG8_STAGE(PG8_SA(1, 0), cA + kstep, voffA); PG8_STAGE(PG8_SB(1, 1), cB + hstep + kstep, voffB);
        PG8_WAIT_V(6); PG8_BAR;
    } else {
        PG8_STAGE(PG8_SB(0, 0), cB, voffB); PG8_STAGE(PG8_SA(0, 0), cA, voffA); PG8_STAGE(PG8_SB(0, 1), cB + hstep, voffB); PG8_STAGE(PG8_SA(0, 1), cA + hstep, voffA);
        if (wr == 1) PG8_BAR;
        PG8_WAIT_V(4); PG8_BAR;
        PG8_STAGE(PG8_SB(1, 0), cB + kstep, voffB); PG8_STAGE(PG8_SA(1, 0), cA + kstep, voffA); PG8_STAGE(PG8_SB(1, 1), cB + hstep + kstep, voffB);
        PG8_WAIT_V(6); PG8_BAR;
    }
    for (;;) {
        const bool has_next = S.next(ui + 1, nxt);
        const char* nA = has_next ? (const char*)g.A + (size_t)nxt.pm * tstep : cA; const char* nB = has_next ? (const char*)g.Bt + (size_t)nxt.pn * tstep : cB;
        for (int t = 0; t < nt; t += 2) {
            const bool last = (t == nt - 2);
            const char* a1 = cA + (size_t)(t + 1) * kstep;
            const char* a2 = last ? nA : cA + (size_t)(t + 2) * kstep; const char* b2 = last ? nB : cB + (size_t)(t + 2) * kstep;
            const char* a3 = a2 + kstep; const char* b3 = b2 + kstep;
            if (last && has_next) S.a_ready(nxt);
            if constexpr (SP2) {
            PG8_LDB(B0, 0, 0); PG8_LDB(B1, 0, 1); PG8_SCHED; PG8_LDA(At, 0, 0); PG8_STAGE(PG8_SA(1, 1), a1 + hstep, voffA);
            PG8_WAIT_V(8); PG8_WAIT_L(0); PG8_BAR; PG8_MMA(0, 0, At, B0); PG8_MMA(0, 1, At, B1); PG8_BAR; PG8_SCHED;
            PG8_LDA(At, 0, 1); PG8_STAGE(PG8_SB(0, 0), b2, voffB); PG8_STAGE(PG8_SB(0, 1), b2 + hstep, voffB); PG8_STAGE(PG8_SA(0, 0), a2, voffA);
            PG8_WAIT_V(8); PG8_WAIT_L(0); PG8_BAR; PG8_MMA(1, 0, At, B0); PG8_MMA(1, 1, At, B1); PG8_BAR; PG8_SCHED;
            PG8_LDB(B0, 1, 0); PG8_LDB(B1, 1, 1); PG8_SCHED; PG8_LDA(At, 1, 0); PG8_STAGE(PG8_SA(0, 1), a2 + hstep, voffA);
            PG8_WAIT_V(8); PG8_WAIT_L(0); PG8_BAR; PG8_MMA(0, 0, At, B0); PG8_MMA(0, 1, At, B1); PG8_BAR; PG8_SCHED;
            PG8_LDA(At, 1, 1); PG8_STAGE(PG8_SB(1, 0), b3, voffB); PG8_STAGE(PG8_SB(1, 1), b3 + hstep, voffB); PG8_STAGE(PG8_SA(1, 0), a3, voffA);
            PG8_WAIT_V(8); PG8_WAIT_L(0); PG8_BAR; PG8_MMA(1, 0, At, B0); PG8_MMA(1, 1, At, B1); PG8_BAR; PG8_SCHED;
            } else {
            PG8_LDB(B0, 0, 0); PG8_SCHED; PG8_LDA(At, 0, 0); PG8_STAGE(PG8_SA(1, 1), a1 + hstep, voffA);
            PG8_WAIT_L(8); PG8_BAR; PG8_WAIT_L(0); PG8_MMA(0, 0, At, B0); PG8_BAR; PG8_SCHED;
            PG8_LDB(B1, 0, 1); PG8_STAGE(PG8_SB(0, 0), b2, voffB);
            PG8_BAR; PG8_WAIT_L(0); PG8_MMA(0, 1, At, B1); PG8_BAR;
            PG8_LDA(At, 0, 1); PG8_STAGE(PG8_SA(0, 0), a2, voffA);
            PG8_BAR; PG8_WAIT_L(0); PG8_MMA(1, 0, At, B0); PG8_BAR; PG8_SCHED;
            PG8_STAGE(PG8_SB(0, 1), b2 + hstep, voffB);
            PG8_WAIT_V(6); PG8_BAR; PG8_MMA(1, 1, At, B1); PG8_BAR;
            PG8_LDB(B0, 1, 0); PG8_SCHED; PG8_LDA(At, 1, 0); PG8_STAGE(PG8_SA(0, 1), a2 + hstep, voffA);
            PG8_WAIT_L(8); PG8_BAR; PG8_WAIT_L(0); PG8_MMA(0, 0, At, B0); PG8_BAR; PG8_SCHED;
            PG8_LDB(B1, 1, 1); PG8_STAGE(PG8_SB(1, 0), b3, voffB);
            PG8_BAR; PG8_WAIT_L(0); PG8_MMA(0, 1, At, B1); PG8_BAR;
            PG8_LDA(At, 1, 1); PG8_STAGE(PG8_SA(1, 0), a3, voffA);
            PG8_BAR; PG8_WAIT_L(0); PG8_MMA(1, 0, At, B0); PG8_BAR; PG8_SCHED;
            PG8_STAGE(PG8_SB(1, 1), b3 + hstep, voffB);
            PG8_WAIT_V(6); PG8_BAR; PG8_MMA(1, 1, At, B1); PG8_BAR;
            }
        }
        if constexpr (ALIGN_EPI) { if (wr == 0) PG8_BAR; }
        if constexpr (!Epi::AFTER_DRAIN) { E(acc, cur, wr, wc, fr, fq); S.done(cur); }
        if (!has_next) break;
#pragma unroll
        for (int a = 0; a < 2; ++a)
#pragma unroll
            for (int b = 0; b < 2; ++b)
#pragma unroll
                for (int m = 0; m < 4; ++m)
#pragma unroll
                    for (int n = 0; n < 2; ++n) acc[a][b][m][n] = (f32x4){0.f, 0.f, 0.f, 0.f};
        cur = nxt; cA = nA; cB = nB; ++ui;
        if constexpr (ALIGN_EPI) { if (wr == 1) PG8_BAR; }
    }
    PG8_WAIT_V(0);
    if constexpr (!ALIGN_EPI) { if (wr == 0) PG8_BAR; }
    PG8_BAR;
    if constexpr (Epi::AFTER_DRAIN) { E.fused(acc, cur, wr, wc, fr, fq, lds, wid, lane); S.done(cur); }
#undef PG8_SA
#undef PG8_SB
#undef PG8_STAGE
#undef PG8_LDA
#undef PG8_LDB
#undef PG8_MMA
#undef PG8_WAIT_V
#undef PG8_WAIT_L
#undef PG8_BAR
#undef PG8_SCHED
}
}

#define LAS __attribute__((address_space(3)))
typedef unsigned short bf16;
using pg8::f32x4; using pg8::u32x4; using pg8::bf16x8; using pg8::cvt_pk_bf16; using pg8::settle; using pg8::bflo; using pg8::bfhi; using pg8::sigm;
typedef unsigned u32x2 __attribute__((ext_vector_type(2)));
constexpr int NWAVES = 8;
constexpr int M = 16384, D = 1024, SEQ = 8192, NH = 8, FF = 2816, INW = 9232, NCHUNK = 2048;
constexpr float EPS = 1e-6f;
constexpr size_t MiB = 1u << 20, KiB = 1u << 10;
constexpr size_t WS_CTL = 0, CTL_ZERO_BYTES = 64 * KiB;
constexpr size_t WS_ELAST = 64 * KiB;
constexpr size_t WS_GTAB = 128 * KiB, WS_BTAB = 640 * KiB;
constexpr size_t WS_WIN = 2 * MiB;
constexpr size_t WS_WA = 20 * MiB, WS_WB = 22 * MiB, WS_WO = 24 * MiB, WS_WUP = 26 * MiB, WS_WDN = 37 * MiB;
constexpr size_t WS_R0 = 43 * MiB;
constexpr size_t WS_R1 = 75 * MiB;
constexpr size_t WS_U = 203 * MiB, WS_AQ = 235 * MiB;
constexpr size_t WS_ACT = 163 * MiB;
constexpr size_t WS_SSQP = 139 * MiB;
constexpr size_t WS_END = 256 * MiB;
constexpr int LDS_MISC = 147456, LDS_BYTES = 147456 + 256;
constexpr int CW_BAR = 1024;

__device__ __forceinline__ int tid_fresh() { int t = threadIdx.x; asm volatile("" : "+v"(t)); return t; }
#define LDS_WAIT() asm volatile("s_waitcnt lgkmcnt(0)" ::: "memory")
#define MFMA16(a, b, c) __builtin_amdgcn_mfma_f32_16x16x32_bf16((a), (b), (c), 0, 0, 0)
__device__ __forceinline__ float wave_sum(float v) {
#pragma unroll
    for (int o = 1; o < 64; o <<= 1) v += __shfl_xor(v, o);
    return v;
}
__device__ __forceinline__ float silu_f(float x) { return x / (1.0f + __expf(-x)); }
__device__ __forceinline__ bf16x8 pack8(const float (&y)[8]) { u32x4 w; w.x = cvt_pk_bf16(y[0], y[1]); w.y = cvt_pk_bf16(y[2], y[3]); w.z = cvt_pk_bf16(y[4], y[5]); w.w = cvt_pk_bf16(y[6], y[7]); return __builtin_bit_cast(bf16x8, w); }
__device__ __forceinline__ bf16x8 pack44(const f32x4 a, const f32x4 b) { u32x4 w; w.x = cvt_pk_bf16(a[0], a[1]); w.y = cvt_pk_bf16(a[2], a[3]); w.z = cvt_pk_bf16(b[0], b[1]); w.w = cvt_pk_bf16(b[2], b[3]); return __builtin_bit_cast(bf16x8, w); }

#define XB_TMO      128
#define XB_XCNT(j)  (256  + 64 * (j))
#define XB_XSUB(j)  (1280 + 64 * (j))
#define XB_XGEN(j)  (2304 + 64 * (j))
#define XB_TOP      3328
#define XB_TOPGEN   3392
#define XCD_BAR_WORDS 3456
#define XB_SPIN_CAP (1u << 18)

__device__ __forceinline__ unsigned xb_ld(unsigned* p)              { return __hip_atomic_load(p, __ATOMIC_RELAXED, __HIP_MEMORY_SCOPE_AGENT); }
__device__ __forceinline__ unsigned xb_add(unsigned* p, unsigned v) { return __hip_atomic_fetch_add(p, v, __ATOMIC_RELAXED, __HIP_MEMORY_SCOPE_AGENT); }
__device__ __forceinline__ unsigned xb_xcc_id() { return (unsigned)__builtin_amdgcn_s_getreg((3 << 11) | 20) & 0xFu; }
#define XB_SPIN(cond, bar) do { unsigned _sp = 0; while (cond) { __builtin_amdgcn_s_sleep(1); \
    if ((++_sp & 255u) == 0u) { if (xb_ld(&(bar)[XB_TMO])) break; if (_sp > XB_SPIN_CAP) { atomicAdd(&(bar)[XB_TMO], 1u); break; } } } } while (0)

struct XcdBarrier {
    unsigned* bar; unsigned x;
    volatile LAS unsigned* st;
};

__device__ __forceinline__ XcdBarrier xcd_barrier_post(unsigned* bar, volatile LAS unsigned* st) {
    XcdBarrier b; b.bar = bar; b.x = xb_xcc_id(); b.st = st;
    if (threadIdx.x == 0) (void)xb_add(&bar[XB_XCNT(b.x)], 1u);
    return b;
}
__device__ __forceinline__ void xcd_barrier_complete(unsigned* bar, unsigned x, unsigned& nloc, unsigned& nx) {
    const unsigned G = gridDim.x * gridDim.y * gridDim.z;
    unsigned sum, cnt, mine, sp = 0u;
    for (;;) {
        sum = 0u; cnt = 0u; mine = 0u;
#pragma unroll
        for (unsigned j = 0; j < 16; ++j) { const unsigned c = xb_ld(&bar[XB_XCNT(j)]); sum += c; cnt += (c > 0u) ? 1u : 0u; mine = (j == x) ? c : mine; }
        if (sum == G) break;
        __builtin_amdgcn_s_sleep(1);
        if ((++sp & 255u) == 0u) { if (xb_ld(&bar[XB_TMO])) break; if (sp > XB_SPIN_CAP) { atomicAdd(&bar[XB_TMO], 1u); break; } }
    }
    nloc = mine > 0u ? mine : 1u; nx = cnt > 0u ? cnt : 1u;
}

__device__ __forceinline__ void xcd_barrier(const XcdBarrier& b) {
    asm volatile("s_waitcnt vmcnt(0)" ::: "memory");
    __syncthreads();
    if (threadIdx.x == 0) {
        unsigned* bar = b.bar;
        __builtin_amdgcn_s_waitcnt(0);
        unsigned nloc = b.st[0], nx = b.st[1];
        if (nloc == 0u) { xcd_barrier_complete(bar, b.x, nloc, nx); b.st[0] = nloc; b.st[1] = nx; }
        const unsigned old = xb_add(&bar[XB_XSUB(b.x)], 1u);
        const unsigned gen = old / nloc;
        if (old + 1u == (gen + 1u) * nloc) {
            __builtin_amdgcn_fence(__ATOMIC_RELEASE, "agent");
            asm volatile("s_waitcnt vmcnt(0)" ::: "memory");
            const unsigned og = xb_add(&bar[XB_TOP], 1u);
            const unsigned tg = og / nx;
            if (og + 1u == (tg + 1u) * nx) xb_add(&bar[XB_TOPGEN], 1u);
            else XB_SPIN(xb_ld(&bar[XB_TOPGEN]) == tg, bar);
            __builtin_amdgcn_fence(__ATOMIC_ACQUIRE, "agent");
            xb_add(&bar[XB_XGEN(b.x)], 1u);
            asm volatile("s_waitcnt vmcnt(0)" ::: "memory");
        } else {
            XB_SPIN(xb_ld(&bar[XB_XGEN(b.x)]) == gen, bar);
            __builtin_amdgcn_fence(__ATOMIC_ACQUIRE, "agent");
            asm volatile("s_waitcnt vmcnt(0)" ::: "memory");
        }
    }
    __syncthreads();
}

__device__ __forceinline__ void transpose_item(const float* W, int ldw, int K, int ncols, bf16* WT, int row_off, LAS float* scr, int item, int lane, const float* kscale = nullptr) {
    const int nblk = ncols / 32, kb = item / nblk, nb = item % nblk, k0 = 64 * kb, n0 = 32 * nb;
    f32x4 v[8];
#pragma unroll
    for (int i = 0; i < 8; ++i) v[i] = *(const f32x4*)(W + (size_t)(k0 + 8 * i + (lane >> 3)) * ldw + n0 + 4 * (lane & 7));
#pragma unroll
    for (int i = 0; i < 8; ++i) { LAS float* p = scr + (8 * i + (lane >> 3)) * 33 + 4 * (lane & 7); const float ksc = kscale ? kscale[k0 + 8 * i + (lane >> 3)] : 1.0f; p[0] = v[i].x * ksc; p[1] = v[i].y * ksc; p[2] = v[i].z * ksc; p[3] = v[i].w * ksc; }
    LDS_WAIT();
    const int c = lane & 7;
#pragma unroll
    for (int j = 0; j < 4; ++j) { const int n = (lane >> 3) + 8 * j; const LAS float* s = scr + (8 * c) * 33 + n;
        u32x4 o; o.x = cvt_pk_bf16(s[0 * 33], s[1 * 33]); o.y = cvt_pk_bf16(s[2 * 33], s[3 * 33]); o.z = cvt_pk_bf16(s[4 * 33], s[5 * 33]); o.w = cvt_pk_bf16(s[6 * 33], s[7 * 33]);
        *(u32x4*)(WT + (size_t)(row_off + n0 + n) * K + k0 + 8 * c) = o; }
    LDS_WAIT();
}
__device__ __forceinline__ void phase_weights(LAS unsigned char* lds, const float* w_in, const float* w_a, const float* w_b, const float* w_o, const float* w_up, const float* w_dn, const float* g_ffn, unsigned char* ws, int part, int wg, int nwg) {
    const int lane = tid_fresh() & 63, wave = __builtin_amdgcn_readfirstlane(tid_fresh() >> 6);
    LAS float* scr = (LAS float*)(lds + wave * 8448);
    const int gw = wg * NWAVES + wave, NGW = nwg * NWAVES;
    constexpr int I0 = 16 * 128, I1 = 16 * 96, I2 = 16 * 64, I3 = 16 * 32, I4 = 16 * 176, I5 = 44 * 32;
    constexpr int NITEMS = I0 + I1 + I2 + 3 * I3 + I4 + I5;
    bf16* win = (bf16*)(ws + WS_WIN);
    constexpr int ISPLIT = I0 + I1 + I2;
    for (int it = (part == 1 ? ISPLIT : 0) + gw; it < (part == 0 ? ISPLIT : NITEMS); it += NGW) {
        int r = it;
        if (r < I0) { transpose_item(w_in + 3072, INW, D, 4096, win, 0, scr, r, lane); continue; } r -= I0;
        if (r < I1) { transpose_item(w_in, INW, D, 3072, win, 4096, scr, r, lane); continue; } r -= I1;
        if (r < I2) { transpose_item(w_in + 7184, INW, D, 2048, win, 7168, scr, r, lane); continue; } r -= I2;
        if (r < I3) { transpose_item(w_a, D, D, D, (bf16*)(ws + WS_WA), 0, scr, r, lane); continue; } r -= I3;
        if (r < I3) { transpose_item(w_b, D, D, D, (bf16*)(ws + WS_WB), 0, scr, r, lane); continue; } r -= I3;
        if (r < I3) { transpose_item(w_o, D, D, D, (bf16*)(ws + WS_WO), 0, scr, r, lane); continue; } r -= I3;
        if (r < I4) { const int n0 = 32 * (r % 176), j = (n0 < FF) ? n0 : n0 - FF, dst0 = (j / 128) * 256 + (j % 128) + ((n0 < FF) ? 0 : 128);
            transpose_item(w_up, 2 * FF, D, 2 * FF, (bf16*)(ws + WS_WUP), dst0 - n0, scr, r, lane, g_ffn); continue; } r -= I4;
        transpose_item(w_dn, D, FF, D, (bf16*)(ws + WS_WDN), 0, scr, r, lane);
    }
}
template <int MODE>
__device__ __forceinline__ void phase_norm(LAS unsigned char* lds, const float* x, const float* g, bf16* ob, float* of, const float* w_in, const float* A_log, const float* dt_bias, float* gtab, float* btab) {
    const int tid = tid_fresh(), lane = tid & 63, wave = __builtin_amdgcn_readfirstlane(tid >> 6);
    LAS float* slab = (LAS float*)lds;
    if (MODE == 1) {
        for (int i = tid; i < 4096; i += NWAVES * 64) { const int k = i >> 2, c4 = i & 3; const int p = ((k >> 8) * 4 + (k & 3)) * 64 + ((k >> 2) & 63);
            const f32x4 v = *(const f32x4*)(w_in + (size_t)k * INW + 7168 + 4 * c4); *(LAS f32x4*)(slab + p * 20 + 4 * c4) = v; }
        __syncthreads();
    }
    f32x4 gv[4];
#pragma unroll
    for (int j = 0; j < 4; ++j) gv[j] = *((const f32x4*)g + lane + 64 * j);
    const int gw = blockIdx.x * NWAVES + wave, NGW = gridDim.x * NWAVES;
    f32x4 cur[2][4], nxt[2][4];
#pragma unroll
    for (int rr = 0; rr < 2; ++rr)
#pragma unroll
        for (int j = 0; j < 4; ++j) { const int m = gw + rr * NGW; cur[rr][j] = (m < M) ? *((const f32x4*)(x + (size_t)m * D) + lane + 64 * j) : (f32x4){0.f, 0.f, 0.f, 0.f}; }
    for (int m0 = gw; m0 < M; m0 += 2 * NGW) {
#pragma unroll
        for (int rr = 0; rr < 2; ++rr)
#pragma unroll
            for (int j = 0; j < 4; ++j) { const int m = m0 + (2 + rr) * NGW; nxt[rr][j] = (m < M) ? *((const f32x4*)(x + (size_t)m * D) + lane + 64 * j) : (f32x4){0.f, 0.f, 0.f, 0.f}; }
#pragma unroll
        for (int rr = 0; rr < 2; ++rr) {
            const int m = m0 + rr * NGW;
            if (m < M) {
                f32x4 v[4]; float s = 0.f;
#pragma unroll
                for (int j = 0; j < 4; ++j) { v[j] = cur[rr][j]; s += (v[j].x * v[j].x + v[j].y * v[j].y) + (v[j].z * v[j].z + v[j].w * v[j].w); }
                const float rstd = rsqrtf(wave_sum(s) * (1.f / D) + EPS);
#pragma unroll
                for (int j = 0; j < 4; ++j) v[j] = v[j] * rstd * gv[j];
                if (MODE == 2) {
                    f32x4* o = (f32x4*)(of + (size_t)m * D) + lane;
#pragma unroll
                    for (int j = 0; j < 4; ++j) o[64 * j] = v[j];
                } else {
                    u32x2* o = (u32x2*)(ob + (size_t)m * D) + lane;
#pragma unroll
                    for (int j = 0; j < 4; ++j) { u32x2 w; w.x = cvt_pk_bf16(v[j].x, v[j].y); w.y = cvt_pk_bf16(v[j].z, v[j].w); o[64 * j] = w; }
                }
                if (MODE == 1) {
                    float acc[16];
#pragma unroll
                    for (int c = 0; c < 16; ++c) acc[c] = 0.f;
#pragma unroll
                    for (int j = 0; j < 4; ++j)
#pragma unroll
                        for (int i = 0; i < 4; ++i) { const float hv = v[j][i]; const LAS f32x4* wp = (const LAS f32x4*)(slab + ((j * 4 + i) * 64 + lane) * 20);
#pragma unroll
                            for (int c4 = 0; c4 < 4; ++c4) { const f32x4 w = wp[c4]; acc[4 * c4 + 0] += hv * w.x; acc[4 * c4 + 1] += hv * w.y; acc[4 * c4 + 2] += hv * w.z; acc[4 * c4 + 3] += hv * w.w; } }
                    float r8[8], r4[4], r2[2], r1;
                    { const bool up = (lane & 32) != 0;
#pragma unroll
                      for (int c = 0; c < 8; ++c) { const float keep = up ? acc[8 + c] : acc[c], send = up ? acc[c] : acc[8 + c]; r8[c] = keep + __shfl_xor(send, 32); } }
                    { const bool up = (lane & 16) != 0;
#pragma unroll
                      for (int c = 0; c < 4; ++c) { const float keep = up ? r8[4 + c] : r8[c], send = up ? r8[c] : r8[4 + c]; r4[c] = keep + __shfl_xor(send, 16); } }
                    { const bool up = (lane & 8) != 0;
#pragma unroll
                      for (int c = 0; c < 2; ++c) { const float keep = up ? r4[2 + c] : r4[c], send = up ? r4[c] : r4[2 + c]; r2[c] = keep + __shfl_xor(send, 8); } }
                    { const bool up = (lane & 4) != 0; const float keep = up ? r2[1] : r2[0], send = up ? r2[0] : r2[1]; r1 = keep + __shfl_xor(send, 4); }
                    r1 += __shfl_xor(r1, 2); r1 += __shfl_xor(r1, 1);
                    const int cidx = ((lane >> 5) & 1) * 8 + ((lane >> 4) & 1) * 4 + ((lane >> 3) & 1) * 2 + ((lane >> 2) & 1);
                    if ((lane & 3) == 0) {
                        if (cidx < 8) { const float xx = r1 + dt_bias[cidx]; const float sp = (xx > 20.f) ? xx : log1pf(__expf(xx)); gtab[(size_t)m * 8 + cidx] = -__expf(A_log[cidx]) * sp; }
                        else btab[(size_t)m * 8 + cidx - 8] = sigm(r1);
                    }
                }
            }
        }
#pragma unroll
        for (int rr = 0; rr < 2; ++rr)
#pragma unroll
            for (int j = 0; j < 4; ++j) cur[rr][j] = nxt[rr][j];
    }
}
__device__ __forceinline__ void phase_convA(const bf16* BG, const bf16* CG, const bf16* XV, const float* cw, bf16* CA) {
    const int gt = blockIdx.x * (NWAVES * 64) + tid_fresh(), NT = gridDim.x * NWAVES * 64;
    for (int idx = gt; idx < (M / 8) * 128; idx += NT) {
        const int r0 = (idx >> 7) * 8, c = (idx & 127) * 8, tb0 = r0 & (SEQ - 1);
        u32x4 a[10], b[10], g[8];
#pragma unroll
        for (int i = 0; i < 10; ++i) { const int rr = r0 - 2 + i; if (tb0 - 2 + i >= 0) { a[i] = *(const u32x4*)(CG + (size_t)rr * D + c); b[i] = *(const u32x4*)(XV + (size_t)rr * D + c); } else { a[i] = (u32x4){0u, 0u, 0u, 0u}; b[i] = a[i]; } }
#pragma unroll
        for (int i = 0; i < 8; ++i) g[i] = *(const u32x4*)(BG + (size_t)(r0 + i) * D + c);
        f32x4 w[3][2];
#pragma unroll
        for (int j = 0; j < 3; ++j) { w[j][0] = *(const f32x4*)(cw + j * D + c); w[j][1] = *(const f32x4*)(cw + j * D + c + 4); }
        float p[10][8];
#pragma unroll
        for (int i = 0; i < 10; ++i) { p[i][0] = bflo(a[i].x) * bflo(b[i].x); p[i][1] = bfhi(a[i].x) * bfhi(b[i].x); p[i][2] = bflo(a[i].y) * bflo(b[i].y); p[i][3] = bfhi(a[i].y) * bfhi(b[i].y);
            p[i][4] = bflo(a[i].z) * bflo(b[i].z); p[i][5] = bfhi(a[i].z) * bfhi(b[i].z); p[i][6] = bflo(a[i].w) * bflo(b[i].w); p[i][7] = bfhi(a[i].w) * bfhi(b[i].w); }
#pragma unroll
        for (int i = 0; i < 8; ++i) { float o[8];
#pragma unroll
            for (int k = 0; k < 8; ++k) o[k] = w[0][k >> 2][k & 3] * p[i][k] + w[1][k >> 2][k & 3] * p[i + 1][k] + w[2][k >> 2][k & 3] * p[i + 2][k];
            u32x4 ww; ww.x = cvt_pk_bf16(o[0] * bflo(g[i].x), o[1] * bfhi(g[i].x)); ww.y = cvt_pk_bf16(o[2] * bflo(g[i].y), o[3] * bfhi(g[i].y));
            ww.z = cvt_pk_bf16(o[4] * bflo(g[i].z), o[5] * bfhi(g[i].z)); ww.w = cvt_pk_bf16(o[6] * bflo(g[i].w), o[7] * bfhi(g[i].w));
            *(u32x4*)(CA + (size_t)(r0 + i) * D + c) = ww; }
    }
}
__device__ __forceinline__ void phase_act(const bf16* UP, const float* cw, bf16* ACT) {
    const int gt = blockIdx.x * (NWAVES * 64) + tid_fresh(), NT = gridDim.x * NWAVES * 64;
    constexpr int CG8 = FF / 8;
    for (int idx = gt; idx < (SEQ / 8) * CG8; idx += NT) {
        const int r0 = (idx / CG8) * 8, c = (idx % CG8) * 8;
        u32x4 a[10], b[10];
#pragma unroll
        for (int i = 0; i < 10; ++i) { const int rr = r0 - 2 + i; if (rr >= 0) { a[i] = *(const u32x4*)(UP + (size_t)rr * (2 * FF) + c); b[i] = *(const u32x4*)(UP + (size_t)rr * (2 * FF) + FF + c); } else { a[i] = (u32x4){0u, 0u, 0u, 0u}; b[i] = a[i]; } }
        f32x4 wg[3][2], wv[3][2];
#pragma unroll
        for (int j = 0; j < 3; ++j) { wg[j][0] = *(const f32x4*)(cw + j * 2 * FF + c); wg[j][1] = *(const f32x4*)(cw + j * 2 * FF + c + 4); wv[j][0] = *(const f32x4*)(cw + j * 2 * FF + FF + c); wv[j][1] = *(const f32x4*)(cw + j * 2 * FF + FF + c + 4); }
#pragma unroll
        for (int i = 0; i < 8; ++i) { float o[8];
#pragma unroll
            for (int k = 0; k < 8; ++k) {
                float ag = 0.f, av = 0.f;
#pragma unroll
                for (int j = 0; j < 3; ++j) { const unsigned ua = ((const unsigned*)&a[i + j])[k >> 1], ub = ((const unsigned*)&b[i + j])[k >> 1];
                    ag += wg[j][k >> 2][k & 3] * ((k & 1) ? bfhi(ua) : bflo(ua)); av += wv[j][k >> 2][k & 3] * ((k & 1) ? bfhi(ub) : bflo(ub)); }
                o[k] = silu_f(ag) * av; }
            u32x4 ww; ww.x = cvt_pk_bf16(o[0], o[1]); ww.y = cvt_pk_bf16(o[2], o[3]); ww.z = cvt_pk_bf16(o[4], o[5]); ww.w = cvt_pk_bf16(o[6], o[7]);
            *(u32x4*)(ACT + (size_t)(r0 + i) * FF + c) = ww; }
    }
}

template <int NORM, int FACT, bool QDOUT>
__device__ __forceinline__ void g1_tile(LAS unsigned char* R, const LAS float* tab, const bf16* src, const float* cw, int row0, int tb0, int lane, int r, int q, bf16x8 (&f)[4][4], u32x4* qd, u32x4* aq) {
    LAS unsigned char* Wl = R + 9520;
#pragma unroll
    for (int i = 0; i < 2; ++i) { const int p = lane + 64 * i; *(LAS f32x4*)(Wl + p * 16) = *(const f32x4*)(cw + (p >> 5) * 3072 + (p & 31) * 4); }
#pragma unroll
    for (int hf = 0; hf < 2; ++hf) {
#pragma unroll
        for (int i = 0; i < 9; ++i) { const int p = lane + 64 * i;
            if (p < 560) { const int lr = p >> 4, cp = p & 15, tok = 32 * hf - 3 + lr; u32x4 v = {0u, 0u, 0u, 0u};
                if (tb0 + tok >= 0) v = *(const u32x4*)(src + (size_t)(row0 + tok) * D + cp * 8);
                *(LAS u32x4*)(R + lr * 272 + cp * 16) = v; } }
        LDS_WAIT();
#pragma unroll
        for (int m2 = 0; m2 < 2; ++m2) {
            const int mi = 2 * hf + m2; float y[4][8]; float ssq = 0.f;
#pragma unroll
            for (int ks = 0; ks < 4; ++ks) {
                const int c0 = 32 * ks + 4 * q;
#pragma unroll
                for (int i = 0; i < 8; ++i) y[ks][i] = 0.f;
#pragma unroll
                for (int j = 0; j < 4; ++j) { const LAS unsigned char* p = R + (16 * m2 + r + j) * 272 + c0 * 2; const u32x2 a = *(const LAS u32x2*)p, b = *(const LAS u32x2*)(p + 32);
                    const f32x4 w0 = *(const LAS f32x4*)(Wl + (j * 128 + c0) * 4), w1 = *(const LAS f32x4*)(Wl + (j * 128 + c0 + 16) * 4);
                    y[ks][0] += w0.x * bflo(a.x); y[ks][1] += w0.y * bfhi(a.x); y[ks][2] += w0.z * bflo(a.y); y[ks][3] += w0.w * bfhi(a.y);
                    y[ks][4] += w1.x * bflo(b.x); y[ks][5] += w1.y * bfhi(b.x); y[ks][6] += w1.z * bflo(b.y); y[ks][7] += w1.w * bfhi(b.y); }
#pragma unroll
                for (int i = 0; i < 8; ++i) { y[ks][i] = silu_f(y[ks][i]); ssq += y[ks][i] * y[ks][i]; }
            }
            float sc = 1.f;
            if (NORM) { ssq += __shfl_xor(ssq, 16); ssq += __shfl_xor(ssq, 32); sc = rsqrtf(ssq + EPS) * (NORM == 2 ? 0.08838834764831845f : 1.0f); }
            if (FACT >= 0) sc *= tab[(FACT >= 0 ? FACT : 0) + 16 * mi + r];
            bf16x8 qrow[4];
#pragma unroll
            for (int ks = 0; ks < 4; ++ks) {
#pragma unroll
                for (int i = 0; i < 8; ++i) y[ks][i] *= sc;
                if (!QDOUT) f[mi][ks] = pack8(y[ks]);
                else { qrow[ks] = pack8(y[ks]); const float e1 = tab[128 + 16 * mi + r];
#pragma unroll
                    for (int i = 0; i < 8; ++i) y[ks][i] *= e1;
                    qd[(mi * 4 + ks) * 64 + lane] = __builtin_bit_cast(u32x4, pack8(y[ks])); }
            }
            if (QDOUT) {
#pragma unroll
                for (int s = 0; s < 2; ++s) {
                    f32x4 d0 = {0.f, 0.f, 0.f, 0.f}, d1 = {0.f, 0.f, 0.f, 0.f};
                    if (2 * s <= mi) {
#pragma unroll
                        for (int ks = 0; ks < 4; ++ks) d0 = MFMA16(f[2 * s][ks], qrow[ks], d0); }
                    if (2 * s + 1 <= mi) {
#pragma unroll
                        for (int ks = 0; ks < 4; ++ks) d1 = MFMA16(f[2 * s + 1][ks], qrow[ks], d1); }
                    const int ip = 16 * mi + r; const float Gq = tab[ip];
                    const int i0 = 32 * s + 4 * q, i1 = i0 + 16; const f32x4 G0 = *(const LAS f32x4*)(tab + i0), G1 = *(const LAS f32x4*)(tab + i1);
#pragma unroll
                    for (int e = 0; e < 4; ++e) { d0[e] = (i0 + e <= ip) ? d0[e] * __expf(Gq - G0[e]) : 0.f; d1[e] = (i1 + e <= ip) ? d1[e] * __expf(Gq - G1[e]) : 0.f; }
                    aq[(mi * 2 + s) * 64 + lane] = __builtin_bit_cast(u32x4, pack44(d0, d1));
                }
            }
        }
        LDS_WAIT();
    }
}
__device__ __forceinline__ void phase_g1(LAS unsigned char* lds, const bf16* Pq, const bf16* Pk, const bf16* Pv, const float* cw, const float* gtab, const float* btab,
                                         float* Elast, u32x4* NW, u32x4* QD, u32x4* KT, u32x4* AQ, u32x2* U) {
    const int lane0 = tid_fresh() & 63, wave = __builtin_amdgcn_readfirstlane(tid_fresh() >> 6);
    for (int chunk = blockIdx.x * NWAVES + wave; chunk < NCHUNK; chunk += gridDim.x * NWAVES) {
        int lane = lane0; asm volatile("" : "+v"(lane));
        const int r = lane & 15, q = lane >> 4;
        LAS unsigned char* R = lds + wave * 18432;
        LAS float* tab = (LAS float*)(R + 16896);
        const int bh = chunk >> 7, n = chunk & 127, b = bh >> 3, h = bh & 7, row0 = b * SEQ + n * 64, tb0 = n * 64, hc = h * 128;
        {   const float g = gtab[(size_t)(row0 + lane) * 8 + h], be = btab[(size_t)(row0 + lane) * 8 + h];
            float gc = g;
#pragma unroll
            for (int o = 1; o < 64; o <<= 1) { const float t = __shfl_up(gc, o); if (lane >= o) gc += t; }
            const float gl = __shfl(gc, 63);
            tab[lane] = gc; tab[64 + lane] = be; tab[128 + lane] = __expf(gc); tab[192 + lane] = __expf(gl - gc); tab[256 + lane] = be * __expf(gc);
            if (lane == 0) Elast[chunk] = __expf(gl); }
        LDS_WAIT();
        bf16x8 kf[4][4];
        g1_tile<1, -1, false>(R, tab, Pk + hc, cw + 1024 + hc, row0, tb0, lane, r, q, kf, nullptr, nullptr);
        g1_tile<2, -1, true>(R, tab, Pq + hc, cw + hc, row0, tb0, lane, r, q, kf, QD + (size_t)chunk * 1024, AQ + (size_t)chunk * 512);
        LAS float* L = (LAS float*)R;
#pragma unroll
        for (int mi = 0; mi < 4; ++mi)
#pragma unroll
            for (int mj = 0; mj <= mi; ++mj) {
                f32x4 acc = {0.f, 0.f, 0.f, 0.f};
#pragma unroll
                for (int ks = 0; ks < 4; ++ks) acc = MFMA16(kf[mj][ks], kf[mi][ks], acc);
                const int i = 16 * mi + r, j0 = 16 * mj + 4 * q; const float Gi = tab[i], bi = tab[64 + i]; const f32x4 Gj = *(const LAS f32x4*)(tab + j0);
                f32x4 o;
#pragma unroll
                for (int e = 0; e < 4; ++e) o[e] = (j0 + e < i) ? bi * acc[e] * __expf(Gi - Gj[e]) : 0.f;
                *(LAS f32x4*)(L + i * 64 + j0) = o;
            }
        LDS_WAIT();
        float Tc[64];
#pragma unroll
        for (int i = 0; i < 64; ++i) {
            float a0 = (lane == i) ? 1.f : 0.f, a1 = 0.f, a2 = 0.f, a3 = 0.f;
#pragma unroll
            for (int j4 = 0; j4 < i; j4 += 4) { const f32x4 l = *(const LAS f32x4*)(L + i * 64 + j4);
                a0 -= l[0] * Tc[j4];
                if (j4 + 1 < i) a1 -= l[1] * Tc[j4 + 1];
                if (j4 + 2 < i) a2 -= l[2] * Tc[j4 + 2];
                if (j4 + 3 < i) a3 -= l[3] * Tc[j4 + 3]; }
            Tc[i] = (a0 + a1) + (a2 + a3);
            if ((i & 3) == 3) __builtin_amdgcn_sched_barrier(0);
        }
        LDS_WAIT();
        { LAS unsigned short* Ti = (LAS unsigned short*)R;
#pragma unroll
          for (int i = 0; i < 64; ++i) Ti[i * 64 + lane] = (unsigned short)(cvt_pk_bf16(Tc[i], 0.f) & 0xffffu); }
        LDS_WAIT();
        bf16x8 Tf[4][2];
#pragma unroll
        for (int mi = 0; mi < 4; ++mi)
#pragma unroll
            for (int s = 0; s < 2; ++s) { const LAS unsigned char* p = R + ((16 * mi + r) * 64 + 32 * s + 4 * q) * 2; const u32x2 a = *(const LAS u32x2*)p, bb = *(const LAS u32x2*)(p + 32);
                u32x4 w; w.x = a.x; w.y = a.y; w.z = bb.x; w.w = bb.y; Tf[mi][s] = __builtin_bit_cast(bf16x8, w); }
        LDS_WAIT();
#pragma unroll
        for (int mi = 0; mi < 4; ++mi)
#pragma unroll
            for (int ks = 0; ks < 4; ++ks) { LAS unsigned char* p = R + (16 * mi + r) * 264 + (32 * ks + 4 * q) * 2; const u32x4 w = __builtin_bit_cast(u32x4, kf[mi][ks]);
                u32x2 lo; lo.x = w.x; lo.y = w.y; u32x2 hi; hi.x = w.z; hi.y = w.w; *(LAS u32x2*)p = lo; *(LAS u32x2*)(p + 32) = hi; }
        LDS_WAIT();
        {   float e2r[2][8], e3r[2][8];
#pragma unroll
            for (int s = 0; s < 2; ++s)
#pragma unroll
                for (int jj = 0; jj < 8; ++jj) { const int tok = 32 * s + 16 * (jj >> 2) + 4 * q + (jj & 3); e2r[s][jj] = tab[192 + tok]; e3r[s][jj] = tab[256 + tok]; }
#pragma unroll 1
            for (int ks = 0; ks < 4; ++ks) {
                bf16x8 kb[2][2];
#pragma unroll
                for (int t = 0; t < 2; ++t)
#pragma unroll
                    for (int s = 0; s < 2; ++s) { const int dj = 2 * ks + t; float kd[8], kg[8];
#pragma unroll
                        for (int jj = 0; jj < 8; ++jj) { const int tok = 32 * s + 16 * (jj >> 2) + 4 * q + (jj & 3);
                            const float f = __uint_as_float((unsigned)(*(const LAS unsigned short*)(R + tok * 264 + (16 * dj + r) * 2)) << 16); kd[jj] = f * e2r[s][jj]; kg[jj] = f * e3r[s][jj]; }
                        KT[(((size_t)chunk * 8 + dj) * 2 + s) * 64 + lane] = __builtin_bit_cast(u32x4, pack8(kd)); kb[t][s] = pack8(kg); }
#pragma unroll
                for (int mi = 0; mi < 4; ++mi) { f32x4 a0 = {0.f, 0.f, 0.f, 0.f}, a1 = {0.f, 0.f, 0.f, 0.f};
#pragma unroll
                    for (int s = 0; s < 2; ++s) { a0 = MFMA16(kb[0][s], Tf[mi][s], a0); a1 = MFMA16(kb[1][s], Tf[mi][s], a1); }
                    NW[(((size_t)chunk * 4 + mi) * 4 + ks) * 64 + lane] = __builtin_bit_cast(u32x4, pack44(-a0, -a1)); }
            } }
        LDS_WAIT();
        {   bf16x8 vf[4][4];
            g1_tile<0, 64, false>(R, tab, Pv + hc, cw + 2048 + hc, row0, tb0, lane, r, q, vf, nullptr, nullptr);
#pragma unroll
            for (int mi = 0; mi < 4; ++mi)
#pragma unroll
                for (int ks = 0; ks < 4; ++ks) { LAS unsigned char* p = R + (16 * mi + r) * 264 + (32 * ks + 4 * q) * 2; const u32x4 w = __builtin_bit_cast(u32x4, vf[mi][ks]);
                    u32x2 lo; lo.x = w.x; lo.y = w.y; u32x2 hi; hi.x = w.z; hi.y = w.w; *(LAS u32x2*)p = lo; *(LAS u32x2*)(p + 32) = hi; } }
        LDS_WAIT();
#pragma unroll 1
        for (int es = 0; es < 8; ++es) {
            bf16x8 vb[2];
#pragma unroll
            for (int s = 0; s < 2; ++s) { unsigned hw[8];
#pragma unroll
                for (int jj = 0; jj < 8; ++jj) { const int tok = 32 * s + 16 * (jj >> 2) + 4 * q + (jj & 3); hw[jj] = *(const LAS unsigned short*)(R + tok * 264 + (16 * es + r) * 2); }
                u32x4 w; w.x = hw[0] | (hw[1] << 16); w.y = hw[2] | (hw[3] << 16); w.z = hw[4] | (hw[5] << 16); w.w = hw[6] | (hw[7] << 16); vb[s] = __builtin_bit_cast(bf16x8, w); }
#pragma unroll
            for (int mi = 0; mi < 4; ++mi) { f32x4 a = {0.f, 0.f, 0.f, 0.f};
#pragma unroll
                for (int s = 0; s < 2; ++s) a = MFMA16(Tf[mi][s], vb[s], a);
                settle(a);
                u32x2 w; w.x = cvt_pk_bf16(a[0], a[1]); w.y = cvt_pk_bf16(a[2], a[3]); U[(((size_t)chunk * 8 + es) * 4 + mi) * 64 + lane] = w; }
        }
        LDS_WAIT();
    }
}
constexpr int SCAN_NS = 1, SCAN_G = 8 / SCAN_NS, SCAN_WGS = 128 / SCAN_NS;
constexpr int SCAN_REC = 32768 + 2048 + 256;
__device__ __forceinline__ void settle4(f32x4& a, f32x4& b, f32x4& c, f32x4& d) { asm volatile("s_nop 15\n\ts_nop 3" : "+v"(a), "+v"(b), "+v"(c), "+v"(d)); }
__device__ __forceinline__ void phase_scan(LAS unsigned char* lds, const u32x4* NW, const u32x4* KT, const u32x2* U, const float* Elast, u32x4* SC, u32x4* VC) {
    if (blockIdx.x >= SCAN_WGS) return;
    const int tid = tid_fresh(), lane = tid & 63, wave = __builtin_amdgcn_readfirstlane(tid >> 6);
    const int xcd = blockIdx.x & 7, kk = blockIdx.x >> 3, bh = xcd * 2 + kk / SCAN_G, es = (kk % SCAN_G) * SCAN_NS + (wave & (SCAN_NS - 1)), chunk0 = bh * 128;
    const bool loader = wave >= 4, comp = wave < SCAN_NS;
    const int lt = tid & 255;
#define SCAN_BAR() do { asm volatile("s_waitcnt lgkmcnt(0)" ::: "memory"); __builtin_amdgcn_s_barrier(); asm volatile("" ::: "memory"); } while (0)
    if (loader) {
        u32x4 RQ[4][9];
        const int es0 = (kk % SCAN_G) * SCAN_NS;
#define SCAN_LOAD(RR, ch) do { _Pragma("unroll") for (int _i = 0; _i < 4; ++_i) { RR[_i] = NW[(size_t)(ch) * 1024 + _i * 256 + lt]; RR[4 + _i] = KT[(size_t)(ch) * 1024 + _i * 256 + lt]; } \
        if (lt < 128) RR[8] = ((const u32x4*)U)[((size_t)(ch) * 8 + es0) * 128 + lt]; else if (lt == 128) { const float _e = Elast[(ch)]; RR[8].x = __float_as_uint(_e); } } while (0)
#define SCAN_PUT(RR, buf) do { _Pragma("unroll") for (int _i = 0; _i < 8; ++_i) *(LAS u32x4*)(lds + (buf) * SCAN_REC + (_i * 256 + lt) * 16) = RR[_i]; \
        if (lt <= 128) *(LAS u32x4*)(lds + (buf) * SCAN_REC + 32768 + lt * 16) = RR[8]; } while (0)
        SCAN_LOAD(RQ[0], chunk0); SCAN_PUT(RQ[0], 0); SCAN_LOAD(RQ[1], chunk0 + 1); SCAN_LOAD(RQ[2], chunk0 + 2); SCAN_LOAD(RQ[3], chunk0 + 3); SCAN_LOAD(RQ[0], chunk0 + 4);
        SCAN_BAR();
#define SCAN_LSTEP(n, j) do { if ((n) + 1 < 128) SCAN_PUT(RQ[((j) + 1) & 3], ((j) + 1) & 1); if ((n) + 5 < 128) SCAN_LOAD(RQ[((j) + 1) & 3], chunk0 + (n) + 5); SCAN_BAR(); } while (0)
        for (int n = 0; n < 128; n += 4) { SCAN_LSTEP(n, 0); SCAN_LSTEP(n + 1, 1); SCAN_LSTEP(n + 2, 2); SCAN_LSTEP(n + 3, 3); }
#undef SCAN_LSTEP
#undef SCAN_LOAD
#undef SCAN_PUT
    } else if (comp) {
        SCAN_BAR();
        f32x4 S[8];
#pragma unroll
        for (int di = 0; di < 8; ++di) S[di] = (f32x4){0.f, 0.f, 0.f, 0.f};
        for (int n = 0; n < 128; ++n) {
            const int chunk = chunk0 + n; const LAS unsigned char* base = lds + (n & 1) * SCAN_REC;
            bf16x8 af[16], kf[16];
#pragma unroll
            for (int i = 0; i < 16; ++i) af[i] = *(const LAS bf16x8*)(base + (i * 64 + lane) * 16);
#pragma unroll
            for (int i = 0; i < 16; ++i) kf[i] = *(const LAS bf16x8*)(base + 16384 + (i * 64 + lane) * 16);
            __builtin_amdgcn_sched_barrier(0);
            u32x2 uc[4];
#pragma unroll
            for (int mi = 0; mi < 4; ++mi) uc[mi] = *(const LAS u32x2*)(base + 32768 + ((wave & (SCAN_NS - 1)) * 256 + mi * 64 + lane) * 8);
            const float e = *(const LAS float*)(base + 32768 + 2048);
            bf16x8 Sfr[4];
#pragma unroll
            for (int ks = 0; ks < 4; ++ks) { Sfr[ks] = pack44(S[2 * ks], S[2 * ks + 1]); SC[(((size_t)chunk * 8 + es) * 4 + ks) * 64 + lane] = __builtin_bit_cast(u32x4, Sfr[ks]); }
            f32x4 vn[4];
#pragma unroll
            for (int mi = 0; mi < 4; ++mi) { vn[mi][0] = bflo(uc[mi].x); vn[mi][1] = bfhi(uc[mi].x); vn[mi][2] = bflo(uc[mi].y); vn[mi][3] = bfhi(uc[mi].y); }
#pragma unroll
            for (int ks = 0; ks < 4; ++ks)
#pragma unroll
                for (int mi = 0; mi < 4; ++mi) vn[mi] = MFMA16(af[mi * 4 + ks], Sfr[ks], vn[mi]);
            settle4(vn[0], vn[1], vn[2], vn[3]);
            bf16x8 Vfr[2];
#pragma unroll
            for (int s = 0; s < 2; ++s) { Vfr[s] = pack44(vn[2 * s], vn[2 * s + 1]); VC[(((size_t)chunk * 8 + es) * 2 + s) * 64 + lane] = __builtin_bit_cast(u32x4, Vfr[s]); }
#pragma unroll
            for (int di = 0; di < 8; ++di) S[di] = S[di] * e;
#pragma unroll
            for (int s = 0; s < 2; ++s)
#pragma unroll
                for (int di = 0; di < 8; ++di) S[di] = MFMA16(kf[di * 2 + s], Vfr[s], S[di]);
            SCAN_BAR();
        }
    } else {
        for (int n = 0; n < 129; ++n) SCAN_BAR();
    }
#undef SCAN_BAR
}
__device__ __forceinline__ void phase_gout(const u32x4* QD, const u32x4* AQ, const u32x4* SC, const u32x4* VC, const bf16* Z, const float* ng, bf16* OB) {
    const int lane0 = tid_fresh() & 63, wave = __builtin_amdgcn_readfirstlane(tid_fresh() >> 6);
    for (int chunk = blockIdx.x * NWAVES + wave; chunk < NCHUNK; chunk += gridDim.x * NWAVES) {
        int lane = lane0; asm volatile("" : "+v"(lane)); const int c = lane & 15, q = lane >> 4;
        const int bh = chunk >> 7, n = chunk & 127, b = bh >> 3, h = bh & 7, row0 = b * SEQ + n * 64;
#pragma unroll 1
        for (int mp = 0; mp < 2; ++mp) {
            bf16x8 qa[2][4], aa[2][2];
#pragma unroll
            for (int m2 = 0; m2 < 2; ++m2) {
#pragma unroll
                for (int ks = 0; ks < 4; ++ks) qa[m2][ks] = __builtin_bit_cast(bf16x8, QD[(((size_t)chunk * 4 + 2 * mp + m2) * 4 + ks) * 64 + lane]);
#pragma unroll
                for (int s = 0; s < 2; ++s) aa[m2][s] = __builtin_bit_cast(bf16x8, AQ[(((size_t)chunk * 4 + 2 * mp + m2) * 2 + s) * 64 + lane]); }
            f32x4 o[2][8];
#pragma unroll
            for (int es = 0; es < 8; ++es) {
                bf16x8 sb[4], vb[2];
#pragma unroll
                for (int ks = 0; ks < 4; ++ks) sb[ks] = __builtin_bit_cast(bf16x8, SC[(((size_t)chunk * 8 + es) * 4 + ks) * 64 + lane]);
#pragma unroll
                for (int s = 0; s < 2; ++s) vb[s] = __builtin_bit_cast(bf16x8, VC[(((size_t)chunk * 8 + es) * 2 + s) * 64 + lane]);
#pragma unroll
                for (int m2 = 0; m2 < 2; ++m2) { f32x4 a = {0.f, 0.f, 0.f, 0.f};
#pragma unroll
                    for (int ks = 0; ks < 4; ++ks) a = MFMA16(sb[ks], qa[m2][ks], a);
#pragma unroll
                    for (int s = 0; s < 2; ++s) a = MFMA16(vb[s], aa[m2][s], a);
                    o[m2][es] = a; }
            }
#pragma unroll
            for (int m2 = 0; m2 < 2; ++m2) {
                float ss = 0.f;
#pragma unroll
                for (int es = 0; es < 8; ++es) { const f32x4 t = o[m2][es] * o[m2][es]; ss += (t[0] + t[1]) + (t[2] + t[3]); }
                ss += __shfl_xor(ss, 16); ss += __shfl_xor(ss, 32);
                const float rstd = rsqrtf(ss * (1.f / 128.f) + EPS);
                const size_t rowoff = (size_t)(row0 + 16 * (2 * mp + m2) + c) * D + h * 128 + 4 * q;
#pragma unroll
                for (int es = 0; es < 8; ++es) { const f32x4 gc = *(const f32x4*)(ng + 16 * es + 4 * q); const u32x2 zz = *(const u32x2*)(Z + rowoff + 16 * es);
                    const f32x4 v = o[m2][es] * rstd * gc;
                    u32x2 w; w.x = cvt_pk_bf16(v[0] * silu_f(bflo(zz.x)), v[1] * silu_f(bfhi(zz.x))); w.y = cvt_pk_bf16(v[2] * silu_f(bflo(zz.y)), v[3] * silu_f(bfhi(zz.y)));
                    *(u32x2*)(OB + rowoff + 16 * es) = w; }
            }
        }
    }
}

struct Args { const float* in[16]; float* out; unsigned char* ws; };
#ifndef USE_CG_ALL
#define USE_CG_ALL 0
#endif
__global__ void __launch_bounds__(NWAVES * 64, 2) fwd_megakernel(Args args) {
    extern __shared__ __attribute__((aligned(16))) unsigned char lds_raw[];
    LAS unsigned char* lds = (LAS unsigned char*)lds_raw;
    cg::grid_group grid = cg::this_grid();
    const int tid = threadIdx.x;
    unsigned char* ws = args.ws;
    volatile LAS unsigned* MISC = (volatile LAS unsigned*)(lds + LDS_MISC);
    if (tid < 64) ((LAS unsigned*)(lds + LDS_MISC))[tid] = 0u;
    __syncthreads();
    XcdBarrier bar = xcd_barrier_post((unsigned*)(ws + WS_CTL) + CW_BAR, MISC);
    const float* x = args.in[0]; float* out = args.out;
    bf16* R0 = (bf16*)(ws + WS_R0);
    bf16* R1 = (bf16*)(ws + WS_R1);
    constexpr size_t MD = (size_t)M * D;
    float* gtab = (float*)(ws + WS_GTAB); float* btab = (float*)(ws + WS_BTAB); float* elast = (float*)(ws + WS_ELAST);
    bf16* win = (bf16*)(ws + WS_WIN);
#define SEAM() xcd_barrier(bar)
#define GEMM_B(Ap, Btp, gM, gN, gK, ...) do { pg8::Gemm g{Ap, Btp, gM, gN, gK}; pg8::EpiB eb{__VA_ARGS__}; pg8::StaticOrder S; S.init(gM, gN, (int)gridDim.x, (int)blockIdx.x); \
        pg8::gemm_phase<pg8::EpiB, pg8::StaticOrder, true, true>(lds, g, S, eb); } while (0)
#define GEMM_F2(Ap, Btp, gM, gN, gK, ...) do { pg8::Gemm g{Ap, Btp, gM, gN, gK}; pg8::EpiF2 ef{__VA_ARGS__}; pg8::StaticOrder S; S.init(gM, gN, (int)gridDim.x, (int)blockIdx.x); \
        pg8::gemm_phase<pg8::EpiF2, pg8::StaticOrder, true, true>(lds, g, S, ef); } while (0)
#define GEMM_F(Ap, Btp, gM, gN, gK, ...) do { pg8::Gemm g{Ap, Btp, gM, gN, gK}; pg8::EpiF ef{__VA_ARGS__}; pg8::StaticOrder S; S.init(gM, gN, (int)gridDim.x, (int)blockIdx.x); \
        pg8::gemm_phase<pg8::EpiF, pg8::StaticOrder, true, true>(lds, g, S, ef); } while (0)
    phase_weights(lds, args.in[2], args.in[8], args.in[9], args.in[10], args.in[12], args.in[14], nullptr, ws, 2, (int)blockIdx.x, (int)gridDim.x); __syncthreads();
    phase_norm<1>(lds, x, args.in[1], R0, nullptr, args.in[2], args.in[5], args.in[6], gtab, btab);
    if (gridDim.y == 0x7fff) grid.sync();
    SEAM();
#ifdef DUP_P0
    phase_weights(lds, args.in[2], args.in[8], args.in[9], args.in[10], args.in[12], args.in[14], nullptr, ws, 2, (int)blockIdx.x, (int)gridDim.x); __syncthreads();
    phase_norm<1>(lds, x, args.in[1], R0, nullptr, args.in[2], args.in[5], args.in[6], gtab, btab);
    SEAM();
#endif
    GEMM_B(R0, win, M, 4096, D, R1, D, D, MD, 0, nullptr, nullptr);
    SEAM();
#ifdef DUP_P1
    GEMM_B(R0, win, M, 4096, D, R1, D, D, MD, 0, nullptr, nullptr);
    SEAM();
#endif
#if !defined(NO_G1) && !defined(DBG_NO_GDN)
    phase_g1(lds, R1, R1 + MD, R1 + 2 * MD, args.in[4], gtab, btab, elast, (u32x4*)R0, (u32x4*)out, (u32x4*)((bf16*)out + MD), (u32x4*)(ws + WS_AQ), (u32x2*)(ws + WS_U));
#endif
    SEAM();
#ifdef DUP_G1
    phase_g1(lds, R1, R1 + MD, R1 + 2 * MD, args.in[4], gtab, btab, elast, (u32x4*)R0, (u32x4*)out, (u32x4*)((bf16*)out + MD), (u32x4*)(ws + WS_AQ), (u32x2*)(ws + WS_U));
    SEAM();
#endif
#if !defined(NO_SCAN) && !defined(DBG_NO_GDN)
    phase_scan(lds, (const u32x4*)R0, (const u32x4*)((bf16*)out + MD), (const u32x2*)(ws + WS_U), elast, (u32x4*)R1, (u32x4*)(R1 + 2 * MD));
#endif
    SEAM();
#ifdef DUP_SCAN
    phase_scan(lds, (const u32x4*)R0, (const u32x4*)((bf16*)out + MD), (const u32x2*)(ws + WS_U), elast, (u32x4*)R1, (u32x4*)(R1 + 2 * MD));
    SEAM();
#endif
#ifdef DBG_NO_GDN
    for (size_t i = (size_t)blockIdx.x * 512 + tid; i < MD / 8; i += (size_t)gridDim.x * 512) ((u32x4*)out)[i] = (u32x4){0u, 0u, 0u, 0u};
#else
    phase_gout((const u32x4*)out, (const u32x4*)(ws + WS_AQ), (const u32x4*)R1, (const u32x4*)(R1 + 2 * MD), R1 + 3 * MD, args.in[7], (bf16*)out + MD);
#endif
    phase_norm<0>(lds, x, args.in[1], R0, nullptr, nullptr, nullptr, nullptr, nullptr, nullptr);
    SEAM();
    GEMM_B(R0, win + (size_t)4096 * D, M, 5120, D, R1, D, D, MD, 0, nullptr, nullptr);
    SEAM();
    phase_convA(R1, R1 + MD, R1 + 2 * MD, args.in[3], (bf16*)out);
    SEAM();
#ifdef DUP_EW
    phase_convA(R1, R1 + MD, R1 + 2 * MD, args.in[3], (bf16*)out);
    SEAM();
#endif
    GEMM_B((bf16*)out, (bf16*)(ws + WS_WA), M, D, D, R0, D, 0, 0, 1, R1 + 3 * MD, nullptr);
    SEAM();
    GEMM_B((bf16*)out + MD, (bf16*)(ws + WS_WB), M, D, D, R1, D, 0, 0, 2, R1 + 4 * MD, R0);
    SEAM();
    GEMM_F(R1, (bf16*)(ws + WS_WO), M, D, D, x, out, D);
    SEAM();
    phase_norm<0>(lds, out, args.in[11], R0, nullptr, nullptr, nullptr, nullptr, nullptr, nullptr);
    SEAM();
    {   pg8::StaticOrder SO; SO.init(65 * 256, 2 * FF, (int)gridDim.x, (int)blockIdx.x);
        for (int i = 0;; ++i) {
            pg8::Unit u; if (!SO.next(i, u)) break;
            pg8::Gemm g{R0 + ((long)254 * u.pm - 2) * D, (bf16*)(ws + WS_WUP), 256, 2 * FF, D};
            pg8::OneUnit s1{pg8::Unit{0, u.pn}};
            pg8::EpiAct ea{(bf16*)(ws + WS_ACT), args.in[13], nullptr, u.pm, u.pn, M, SEQ - 1, FF};
            pg8::gemm_phase<pg8::EpiAct, pg8::OneUnit, false, true>(lds, g, s1, ea);
        } }
    SEAM();
    GEMM_F((bf16*)(ws + WS_ACT), (bf16*)(ws + WS_WDN), M, D, FF, out, out, D);
    SEAM();
    phase_norm<2>(lds, out, args.in[15], nullptr, out, nullptr, nullptr, nullptr, nullptr, nullptr);
}

extern "C" void kernel_launch(void* const* d_in, const int* in_sizes, int n_in, void* d_out, int out_size, void* d_ws, size_t ws_size, hipStream_t stream) {
    static int grid = 0;
    if (grid == 0) {
        if (n_in != 16 || out_size != M * D || ws_size < WS_END) { fprintf(stderr, "kernel_launch: unexpected shapes (n_in %d out %d ws %zu)\n", n_in, out_size, ws_size); grid = -1; return; }
        int dev = 0, cus = 0, per_cu = 0;
        (void)hipGetDevice(&dev); (void)hipDeviceGetAttribute(&cus, hipDeviceAttributeMultiprocessorCount, dev);
        (void)hipFuncSetAttribute((const void*)fwd_megakernel, hipFuncAttributeMaxDynamicSharedMemorySize, LDS_BYTES);
        (void)hipOccupancyMaxActiveBlocksPerMultiprocessor(&per_cu, (const void*)fwd_megakernel, NWAVES * 64, LDS_BYTES);
        if (per_cu < 1) { fprintf(stderr, "kernel_launch: occupancy query says %d blocks per CU\n", per_cu); grid = -1; return; }
        grid = cus;
        if (grid < 64) { fprintf(stderr, "kernel_launch: needs >= 64 CUs\n"); grid = -1; return; }
    }
    if (grid < 0) return;
    (void)hipMemsetAsync((char*)d_ws + WS_CTL, 0, CTL_ZERO_BYTES, stream);
    Args a{};
    for (int i = 0; i < 16; ++i) a.in[i] = (const float*)d_in[i];
    a.out = (float*)d_out; a.ws = (unsigned char*)d_ws;
    void* params[] = {&a};
    hipError_t e = hipLaunchCooperativeKernel((const void*)fwd_megakernel, dim3(grid), dim3(NWAVES * 64), params, LDS_BYTES, stream);
    if (e != hipSuccess) fprintf(stderr, "kernel_launch: cooperative launch failed: %s (grid %d)\n", hipGetErrorString(e), grid);
}
```

```cpp
#include <hip/hip_runtime.h>
#include <hip/hip_cooperative_groups.h>
#include <cstdio>
#include <cstdint>
namespace cg = cooperative_groups;
namespace pg8 {
#define PG8_LAS __attribute__((address_space(3)))
typedef unsigned short bf16_t;
typedef short bf16x8 __attribute__((ext_vector_type(8)));
typedef float f32x4 __attribute__((ext_vector_type(4)));
typedef unsigned u32x4 __attribute__((ext_vector_type(4)));
constexpr int BM = 256, BK = 64, HALF = 128, HTB = HALF * BK * 2  , STAGE_BYTES = 8 * HTB, NXCD = 8, WGM = 8;

__host__ __device__ __forceinline__ int lds_byte(int r, int c) { const int st = (r >> 4) * 2 + (c >> 5), rr = r & 15, cc = c & 31, ob = rr * 64 + cc * 2; return st * 1024 + (ob ^ (((ob >> 9) & 1) << 5)); }
__host__ __device__ __forceinline__ void stage_rc(int b, int& R, int& C) { const int st = b / 1024, sb = b % 1024, swz = sb ^ (((sb >> 9) & 1) << 5); R = (st >> 1) * 16 + swz / 64; C = (st & 1) * 32 + (swz % 64) / 2; }
__host__ __device__ __forceinline__ int perm32(int rho) { const int n = rho >> 4, i = rho & 15; return 8 * (i >> 2) + 4 * n + (i & 3); }

struct Unit { int pm, pn; };
struct Gemm { const bf16_t* A; const bf16_t* Bt; int M, N, K; };

struct StaticOrder {
    int nM, nN, nwg, G, c;
    __host__ __device__ __forceinline__ void init(int M, int N, int G_, int c_) { nM = M / BM; nN = N / BM; nwg = nM * nN; G = G_; c = c_; }
    __host__ __device__ __forceinline__ bool next(int i, Unit& u) const {
        const long L = (long)i * G + c; if (L >= nwg) return false;
        int wgid = (int)L; { const int q = nwg / NXCD, r = nwg % NXCD, xcd = wgid % NXCD, off = wgid / NXCD; wgid = (xcd < r ? xcd * (q + 1) : r * (q + 1) + (xcd - r) * q) + off; }
        const int nig = WGM * nN, gid = wgid / nig, fm = gid * WGM, gsz = (nM - fm) < WGM ? (nM - fm) : WGM;
        u.pm = fm + ((wgid % nig) % gsz); u.pn = (wgid % nig) / gsz; return true;
    }
    __device__ __forceinline__ void a_ready(const Unit&) const {}
    __device__ __forceinline__ void done(const Unit&) const {}
};

__device__ __forceinline__ unsigned cvt_pk_bf16(float lo, float hi) { unsigned r; asm volatile("v_cvt_pk_bf16_f32 %0, %1, %2" : "=v"(r) : "v"(lo), "v"(hi)); return r; }
__device__ __forceinline__ void settle(f32x4& a) { asm volatile("s_nop 15\n\ts_nop 3" : "+v"(a)); }
__device__ __forceinline__ float bflo(unsigned u) { return __uint_as_float(u << 16); }
__device__ __forceinline__ float bfhi(unsigned u) { return __uint_as_float(u & 0xffff0000u); }
__device__ __forceinline__ float sigm(float x) { return __builtin_amdgcn_rcpf(1.0f + __expf(-x)); }
struct EpiB {
    static constexpr bool PERM = true, AFTER_DRAIN = false;
    bf16_t* O; int ldc; int split_cols; size_t split_stride; int mode; const bf16_t* G1; const bf16_t* Y;
    __device__ __forceinline__ void operator()(const f32x4 (&acc)[2][2][4][2], const Unit& u, int wr, int wc, int fr, int fq) const {
        const int row0 = u.pm * BM + wr * 64 + fr; int colt = u.pn * BM; bf16_t* base = O;
        if (split_cols) { const int t = colt / split_cols; base += (size_t)t * split_stride; colt -= t * split_cols; }
        const int col0 = colt + wc * 32 + 8 * fq;
        asm volatile("s_nop 15\n\ts_nop 3" ::: "memory");
#pragma unroll
        for (int ai = 0; ai < 2; ++ai)
#pragma unroll
            for (int m = 0; m < 4; ++m) { const size_t roff = (size_t)(row0 + ai * HALF + m * 16) * ldc + col0;
#pragma unroll
                for (int bj = 0; bj < 2; ++bj) { f32x4 v0 = acc[ai][bj][m][0], v1 = acc[ai][bj][m][1];
                    if (mode) { const u32x4 gv = *(const u32x4*)(G1 + roff + bj * HALF);
                        v0[0] *= sigm(bflo(gv.x)); v0[1] *= sigm(bfhi(gv.x)); v0[2] *= sigm(bflo(gv.y)); v0[3] *= sigm(bfhi(gv.y));
                        v1[0] *= sigm(bflo(gv.z)); v1[1] *= sigm(bfhi(gv.z)); v1[2] *= sigm(bflo(gv.w)); v1[3] *= sigm(bfhi(gv.w));
                        if (mode == 2) { const u32x4 yv = *(const u32x4*)(Y + roff + bj * HALF);
                            v0[0] += bflo(yv.x); v0[1] += bfhi(yv.x); v0[2] += bflo(yv.y); v0[3] += bfhi(yv.y);
                            v1[0] += bflo(yv.z); v1[1] += bfhi(yv.z); v1[2] += bflo(yv.w); v1[3] += bfhi(yv.w); } }
                    u32x4 w; w.x = cvt_pk_bf16(v0[0], v0[1]); w.y = cvt_pk_bf16(v0[2], v0[3]); w.z = cvt_pk_bf16(v1[0], v1[1]); w.w = cvt_pk_bf16(v1[2], v1[3]);
                    *(u32x4*)(base + roff + bj * HALF) = w; } }
    }
};
struct EpiF {
    static constexpr bool PERM = false, AFTER_DRAIN = false;
    const float* base; float* out; int ldc;
    __device__ __forceinline__ void operator()(const f32x4 (&acc)[2][2][4][2], const Unit& u, int wr, int wc, int fr, int fq) const {
        const int row0 = u.pm * BM + wr * 64 + fr, col0 = u.pn * BM + wc * 32 + 4 * fq;
#pragma unroll
        for (int ai = 0; ai < 2; ++ai)
#pragma unroll
            for (int m = 0; m < 4; ++m) { const size_t off = (size_t)(row0 + ai * HALF + m * 16) * ldc + col0;
#pragma unroll
                for (int bj = 0; bj < 2; ++bj)
#pragma unroll
                    for (int n = 0; n < 2; ++n) { const f32x4 bs = *(const f32x4*)(base + off + bj * HALF + n * 16); *(f32x4*)(out + off + bj * HALF + n * 16) = bs + acc[ai][bj][m][n]; } }
    }
};

typedef unsigned u32x2 __attribute__((ext_vector_type(2)));
struct EpiF2 {
    static constexpr bool PERM = false, AFTER_DRAIN = false;
    const float* base; float* out; bf16_t* ob; float* ssqp; int ldc;
    __device__ __forceinline__ void operator()(const f32x4 (&acc)[2][2][4][2], const Unit& u, int wr, int wc, int fr, int fq) const {
        const int row0 = u.pm * BM + wr * 64 + fr, col0 = u.pn * BM + wc * 32 + 4 * fq;
#pragma unroll
        for (int ai = 0; ai < 2; ++ai)
#pragma unroll
            for (int m = 0; m < 4; ++m) { const int row = row0 + ai * HALF + m * 16; const size_t off = (size_t)row * ldc + col0; float ss = 0.f;
#pragma unroll
                for (int bj = 0; bj < 2; ++bj)
#pragma unroll
                    for (int n = 0; n < 2; ++n) { const f32x4 bs = *(const f32x4*)(base + off + bj * HALF + n * 16); const f32x4 v = bs + acc[ai][bj][m][n];
                        *(f32x4*)(out + off + bj * HALF + n * 16) = v; ss += (v[0] * v[0] + v[1] * v[1]) + (v[2] * v[2] + v[3] * v[3]);
                        u32x2 w; w.x = cvt_pk_bf16(v[0], v[1]); w.y = cvt_pk_bf16(v[2], v[3]); *(u32x2*)(ob + off + bj * HALF + n * 16) = w; }
                ss += __shfl_xor(ss, 16); ss += __shfl_xor(ss, 32);
                if (fq == 0) ssqp[(size_t)row * 16 + u.pn * 4 + wc] = ss; }
    }
};
struct EpiAct {
    static constexpr bool PERM = true, AFTER_DRAIN = true;
    bf16_t* act; const float* cw; const float* ssqp; int pm, pn, Mrows, seq_mask, ff;
    __device__ __forceinline__ void fused(f32x4 (&acc)[2][2][4][2], const Unit& u, int wr, int wc, int fr, int fq, PG8_LAS unsigned char* lds, int wid, int lane) const {
        asm volatile("s_nop 15\n\ts_nop 3" ::: "memory");
#pragma unroll
        for (int ai = 0; ai < 2; ++ai)
#pragma unroll
            for (int m = 0; m < 4; ++m) { const int row = ai * HALF + wr * 64 + m * 16 + fr, g = 254 * pm - 2 + row; float rs = 1.f;
                if (ssqp != nullptr && g >= 0 && g < Mrows) { const f32x4* sp = (const f32x4*)(ssqp + (size_t)g * 16); const f32x4 s0 = sp[0], s1 = sp[1], s2 = sp[2], s3 = sp[3];
                    rs = rsqrtf((((s0[0] + s0[1]) + (s0[2] + s0[3])) + ((s1[0] + s1[1]) + (s1[2] + s1[3])) + ((s2[0] + s2[1]) + (s2[2] + s2[3])) + ((s3[0] + s3[1]) + (s3[2] + s3[3]))) * (1.0f / 1024.0f) + 1e-6f); }
#ifdef DBG_RS
                rs = 0.7f;
#endif
#pragma unroll
                for (int bj = 0; bj < 2; ++bj) { const f32x4 v0 = acc[ai][bj][m][0] * rs, v1 = acc[ai][bj][m][1] * rs;
                    u32x4 w; w.x = cvt_pk_bf16(v0[0], v0[1]); w.y = cvt_pk_bf16(v0[2], v0[3]); w.z = cvt_pk_bf16(v1[0], v1[1]); w.w = cvt_pk_bf16(v1[2], v1[3]);
                    *(PG8_LAS u32x4*)(lds + row * 528 + (bj * HALF + wc * 32 + 8 * fq) * 2) = w; } }
        asm volatile("s_waitcnt lgkmcnt(0)" ::: "memory"); __builtin_amdgcn_s_barrier(); asm volatile("" ::: "memory");
        const int t = wid * 64 + lane, cg8 = t & 15, lr0 = (t >> 4) * 8;
        u32x4 a[10], b[10];
#pragma unroll
        for (int i = 0; i < 10; ++i) { if (lr0 + i < 256) { a[i] = *(const PG8_LAS u32x4*)(lds + (lr0 + i) * 528 + cg8 * 16); b[i] = *(const PG8_LAS u32x4*)(lds + (lr0 + i) * 528 + 256 + cg8 * 16); } else { a[i] = (u32x4){0u, 0u, 0u, 0u}; b[i] = a[i]; } }
        const int col = pn * HALF + 8 * cg8;
        f32x4 wg[3][2], wv[3][2];
#pragma unroll
        for (int j = 0; j < 3; ++j) { wg[j][0] = *(const f32x4*)(cw + j * 2 * ff + col); wg[j][1] = *(const f32x4*)(cw + j * 2 * ff + col + 4); wv[j][0] = *(const f32x4*)(cw + j * 2 * ff + ff + col); wv[j][1] = *(const f32x4*)(cw + j * 2 * ff + ff + col + 4); }
#pragma unroll
        for (int i = 0; i < 8; ++i) {
            const int lr = lr0 + 2 + i, g = 254 * pm - 2 + lr, tb = g & seq_mask;
            if (lr < 256 && g < Mrows) {
                const float m1 = (tb >= 1) ? 1.f : 0.f, m0 = (tb >= 2) ? 1.f : 0.f;
                float o[8];
#pragma unroll
                for (int k = 0; k < 8; ++k) {
                    const unsigned a0 = a[i][k >> 1], a1 = a[i + 1][k >> 1], a2 = a[i + 2][k >> 1];
                    const unsigned b0 = b[i][k >> 1], b1 = b[i + 1][k >> 1], b2 = b[i + 2][k >> 1];
                    const float ga0 = (k & 1) ? bfhi(a0) : bflo(a0), ga1 = (k & 1) ? bfhi(a1) : bflo(a1), ga2 = (k & 1) ? bfhi(a2) : bflo(a2);
                    const float va0 = (k & 1) ? bfhi(b0) : bflo(b0), va1 = (k & 1) ? bfhi(b1) : bflo(b1), va2 = (k & 1) ? bfhi(b2) : bflo(b2);
                    const float ag = (tb >= 2 ? wg[0][k >> 2][k & 3] * ga0 : 0.f) + (tb >= 1 ? wg[1][k >> 2][k & 3] * ga1 : 0.f) + wg[2][k >> 2][k & 3] * ga2;
                    const float av = (tb >= 2 ? wv[0][k >> 2][k & 3] * va0 : 0.f) + (tb >= 1 ? wv[1][k >> 2][k & 3] * va1 : 0.f) + wv[2][k >> 2][k & 3] * va2;
                    o[k] = ag * __builtin_amdgcn_rcpf(1.0f + __expf(-ag)) * av; }
                (void)m1; (void)m0;
                u32x4 ww; ww.x = cvt_pk_bf16(o[0], o[1]); ww.y = cvt_pk_bf16(o[2], o[3]); ww.z = cvt_pk_bf16(o[4], o[5]); ww.w = cvt_pk_bf16(o[6], o[7]);
                *(u32x4*)(act + (size_t)g * ff + col) = ww;
            }
        }
        asm volatile("s_waitcnt lgkmcnt(0)" ::: "memory"); __builtin_amdgcn_s_barrier(); asm volatile("" ::: "memory");
    }
};
struct OneUnit {
    Unit u;
    __device__ __forceinline__ bool next(int i, Unit& o) const { if (i) return false; o = u; return true; }
    __device__ __forceinline__ void a_ready(const Unit&) const {}
    __device__ __forceinline__ void done(const Unit&) const {}
};

template <class Epi, class Sched, bool ALIGN_EPI = false, bool SP2 = false>
__device__ __forceinline__ void gemm_phase(PG8_LAS unsigned char* lds, const Gemm g, const Sched& S, const Epi& E) {
    int tid = threadIdx.x; asm volatile("" : "+v"(tid)); const int wid = __builtin_amdgcn_readfirstlane(tid >> 6), lane = tid & 63, wr = wid >> 2, wc = wid & 3, fr = lane & 15, fq = lane >> 4;
    const int K = g.K, nt = K / BK;
    unsigned voffA[2], voffB[2];
#pragma unroll
    for (int i = 0; i < 2; ++i) { int R, C; stage_rc(tid * 16 + i * 8192, R, C); const int Rb = Epi::PERM ? ((R & ~31) + perm32(R & 31)) : R;
        voffA[i] = (unsigned)(R * K + C) * 2u; voffB[i] = (unsigned)(Rb * K + C) * 2u; }
    const size_t kstep = (size_t)(BK * 2);
    const size_t hstep = (size_t)HALF * K * 2;
    const size_t tstep = 2 * hstep;
    const unsigned ldsw = (unsigned)wid * 1024u;
    const int aoff = lds_byte(wr * 64 + fr, fq * 8), boff = lds_byte(wc * 32 + fr, fq * 8);
#define PG8_SA(b, h) (((b) * 2 + (h)) * HTB)
#define PG8_SB(b, h) ((4 + (b) * 2 + (h)) * HTB)
#define PG8_STAGE(bufoff, gbase, voff) do { _Pragma("unroll") for (int _i = 0; _i < 2; ++_i) \
        __builtin_amdgcn_global_load_lds((const unsigned*)((const char*)(gbase) + (voff)[_i]), (PG8_LAS unsigned*)(lds + (bufoff) + ldsw + _i * 8192), 16, 0, 0); } while (0)
#define PG8_LDA(dst, b, h) do { _Pragma("unroll") for (int m = 0; m < 4; ++m) _Pragma("unroll") for (int k = 0; k < 2; ++k) dst[m][k] = *(const PG8_LAS bf16x8*)(lds + PG8_SA(b, h) + aoff + m * 2048 + k * 1024); } while (0)
#define PG8_LDB(dst, b, h) do { _Pragma("unroll") for (int n = 0; n < 2; ++n) _Pragma("unroll") for (int k = 0; k < 2; ++k) dst[n][k] = *(const PG8_LAS bf16x8*)(lds + PG8_SB(b, h) + boff + n * 2048 + k * 1024); } while (0)
#define PG8_MMA(ai, bj, At, Bt) do { __builtin_amdgcn_s_setprio(1); _Pragma("unroll") for (int m = 0; m < 4; ++m) _Pragma("unroll") for (int n = 0; n < 2; ++n) _Pragma("unroll") for (int k = 0; k < 2; ++k) \
        acc[ai][bj][m][n] = __builtin_amdgcn_mfma_f32_16x16x32_bf16(Bt[n][k], At[m][k], acc[ai][bj][m][n], 0, 0, 0); __builtin_amdgcn_s_setprio(0); } while (0)
#define PG8_WAIT_V(n) asm volatile("s_waitcnt vmcnt(" #n ")" ::: "memory")
#define PG8_WAIT_L(n) asm volatile("s_waitcnt lgkmcnt(" #n ")" ::: "memory")
#define PG8_BAR __builtin_amdgcn_s_barrier()
#define PG8_SCHED __builtin_amdgcn_sched_barrier(0)
    Unit cur, nxt; int ui = 0;
    if (!S.next(0, cur)) return;
    f32x4 acc[2][2][4][2];
#pragma unroll
    for (int a = 0; a < 2; ++a)
#pragma unroll
        for (int b = 0; b < 2; ++b)
#pragma unroll
            for (int m = 0; m < 4; ++m)
#pragma unroll
                for (int n = 0; n < 2; ++n) acc[a][b][m][n] = (f32x4){0.f, 0.f, 0.f, 0.f};
    bf16x8 At[4][2], B0[2][2], B1[2][2];
    const char* cA = (const char*)g.A + (size_t)cur.pm * tstep; const char* cB = (const char*)g.Bt + (size_t)cur.pn * tstep;
    S.a_ready(cur);
    if constexpr (SP2) {
        PG8_STAGE(PG8_SB(0, 0), cB, voffB); PG8_STAGE(PG8_SB(0, 1), cB + hstep, voffB); PG8_STAGE(PG8_SA(0, 0), cA, voffA); PG8_STAGE(PG8_SA(0, 1), cA + hstep, voffA);
        if (wr == 1) PG8_BAR;
        PG8_WAIT_V(2); PG8_BAR;
        PG8_STAGE(PG8_SB(1, 0), cB + kstep, voffB); PG8_STAGE(PG8_SA(1, 0), cA + kstep, voffA); PG8_STAGE(PG8_SB(1, 1), cB + hstep + kstep, voffB);
        PG8_WAIT_V(6); PG8_BAR;
    } else {
        PG8_STAGE(PG8_SB(0, 0), cB, voffB); PG8_STAGE(PG8_SA(0, 0), cA, voffA); PG8_STAGE(PG8_SB(0, 1), cB + hstep, voffB); PG8_STAGE(PG8_SA(0, 1), cA + hstep, voffA);
        if (wr == 1) PG8_BAR;
        PG8_WAIT_V(4); PG8_BAR;
        PG8_STAGE(PG8_SB(1, 0), cB + kstep, voffB); PG8_STAGE(PG8_SA(1, 0), cA + kstep, voffA); PG8_STAGE(PG8_SB(1, 1), cB + hstep + kstep, voffB);
        PG8_WAIT_V(6); PG8_BAR;
    }
    for (;;) {
        const bool has_next = S.next(ui + 1, nxt);
        const char* nA = has_next ? (const char*)g.A + (size_t)nxt.pm * tstep : cA; const char* nB = has_next ? (const char*)g.Bt + (size_t)nxt.pn * tstep : cB;
        for (int t = 0; t < nt; t += 2) {
            const bool last = (t == nt - 2);
            const char* a1 = cA + (size_t)(t + 1) * kstep;
            const char* a2 = last ? nA : cA + (size_t)(t + 2) * kstep; const char* b2 = last ? nB : cB + (size_t)(t + 2) * kstep;
            const char* a3 = a2 + kstep; const char* b3 = b2 + kstep;
            if (last && has_next) S.a_ready(nxt);
            if constexpr (SP2) {
            PG8_LDB(B0, 0, 0); PG8_LDB(B1, 0, 1); PG8_SCHED; PG8_LDA(At, 0, 0); PG8_STAGE(PG8_SA(1, 1), a1 + hstep, voffA);
            PG8_WAIT_V(8); PG8_WAIT_L(0); PG8_BAR; PG8_MMA(0, 0, At, B0); PG8_MMA(0, 1, At, B1); PG8_BAR; PG8_SCHED;
            PG8_LDA(At, 0, 1); PG8_STAGE(PG8_SB(0, 0), b2, voffB); PG8_STAGE(PG8_SB(0, 1), b2 + hstep, voffB); PG8_STAGE(PG8_SA(0, 0), a2, voffA);
            PG8_WAIT_V(8); PG8_WAIT_L(0); PG8_BAR; PG8_MMA(1, 0, At, B0); PG8_MMA(1, 1, At, B1); PG8_BAR; PG8_SCHED;
            PG8_LDB(B0, 1, 0); PG8_LDB(B1, 1, 1); PG8_SCHED; PG8_LDA(At, 1, 0); PG8_STAGE(PG8_SA(0, 1), a2 + hstep, voffA);
            PG8_WAIT_V(8); PG8_WAIT_L(0); PG8_BAR; PG8_MMA(0, 0, At, B0); PG8_MMA(0, 1, At, B1); PG8_BAR; PG8_SCHED;
            PG8_LDA(At, 1, 1); PG8_STAGE(PG8_SB(1, 0), b3, voffB); PG8_STAGE(PG8_SB(1, 1), b3 + hstep, voffB); PG8_STAGE(PG8_SA(1, 0), a3, voffA);
            PG8_WAIT_V(8); PG8_WAIT_L(0); PG8_BAR; PG8_MMA(1, 0, At, B0); PG8_MMA(1, 1, At, B1); PG8_BAR; PG8_SCHED;
            } else {
            PG8_LDB(B0, 0, 0); PG8_SCHED; PG8_LDA(At, 0, 0); PG8_STAGE(PG8_SA(1, 1), a1 + hstep, voffA);
            PG8_WAIT_L(8); PG8_BAR; PG8_WAIT_L(0); PG8_MMA(0, 0, At, B0); PG8_BAR; PG8_SCHED;
            PG8_LDB(B1, 0, 1); PG8_STAGE(PG8_SB(0, 0), b2, voffB);
            PG8_BAR; PG8_WAIT_L(0); PG8_MMA(0, 1, At, B1); PG8_BAR;
            PG8_LDA(At, 0, 1); PG8_STAGE(PG8_SA(0, 0), a2, voffA);
            PG8_BAR; PG8_WAIT_L(0); PG8_MMA(1, 0, At, B0); PG8_BAR; PG8_SCHED;
            PG8_STAGE(PG8_SB(0, 1), b2 + hstep, voffB);
            PG8_WAIT_V(6); PG8_BAR; PG8_MMA(1, 1, At, B1); PG8_BAR;
            PG8_LDB(B0, 1, 0); PG8_SCHED; PG8_LDA(At, 1, 0); PG8_STAGE(PG8_SA(0, 1), a2 + hstep, voffA);
            PG8_WAIT_L(8); PG8_BAR; PG8_WAIT_L(0); PG8_MMA(0, 0, At, B0); PG8_BAR; PG8_SCHED;
            PG8_LDB(B1, 1, 1); PG8_STAGE(PG8_SB(1, 0), b3, voffB);
            PG8_BAR; PG8_WAIT_L(0); PG8_MMA(0, 1, At, B1); PG8_BAR;
            PG8_LDA(At, 1, 1); PG8_STAGE(PG8_SA(1, 0), a3, voffA);
            PG8_BAR; PG8_WAIT_L(0); PG8_MMA(1, 0, At, B0); PG8_BAR; PG8_SCHED;
            PG8_STAGE(PG8_SB(1, 1), b3 + hstep, voffB);
            PG8_WAIT_V(6); PG8_BAR; PG8_MMA(1, 1, At, B1); PG8_BAR;
            }
        }
        if constexpr (ALIGN_EPI) { if (wr == 0) PG8_BAR; }
        if constexpr (!Epi::AFTER_DRAIN) { E(acc, cur, wr, wc, fr, fq); S.done(cur); }
        if (!has_next) break;
#pragma unroll
        for (int a = 0; a < 2; ++a)
#pragma unroll
            for (int b = 0; b < 2; ++b)
#pragma unroll
                for (int m = 0; m < 4; ++m)
#pragma unroll
                    for (int n = 0; n < 2; ++n) acc[a][b][m][n] = (f32x4){0.f, 0.f, 0.f, 0.f};
        cur = nxt; cA = nA; cB = nB; ++ui;
        if constexpr (ALIGN_EPI) { if (wr == 1) PG8_BAR; }
    }
    PG8_WAIT_V(0);
    if constexpr (!ALIGN_EPI) { if (wr == 0) PG8_BAR; }
    PG8_BAR;
    if constexpr (Epi::AFTER_DRAIN) { E.fused(acc, cur, wr, wc, fr, fq, lds, wid, lane); S.done(cur); }
#undef PG8_SA
#undef PG8_SB
#undef PG8_STAGE
#undef PG8_LDA
#undef PG8_LDB
#undef PG8_MMA
#undef PG8_WAIT_V
#undef PG8_WAIT_L
#undef PG8_BAR
#undef PG8_SCHED
}
}

#define LAS __attribute__((address_space(3)))
typedef unsigned short bf16;
using pg8::f32x4; using pg8::u32x4; using pg8::bf16x8; using pg8::cvt_pk_bf16; using pg8::settle; using pg8::bflo; using pg8::bfhi; using pg8::sigm;
typedef unsigned u32x2 __attribute__((ext_vector_type(2)));
constexpr int NWAVES = 8;
constexpr int M = 16384, D = 1024, SEQ = 8192, NH = 8, FF = 2816, INW = 9232, NCHUNK = 2048;
constexpr float EPS = 1e-6f;
constexpr size_t MiB = 1u << 20, KiB = 1u << 10;
constexpr size_t WS_CTL = 0, CTL_ZERO_BYTES = 64 * KiB;
constexpr size_t WS_ELAST = 64 * KiB;
constexpr size_t WS_GTAB = 128 * KiB, WS_BTAB = 640 * KiB;
constexpr size_t WS_WIN = 2 * MiB;
constexpr size_t WS_WA = 20 * MiB, WS_WB = 22 * MiB, WS_WO = 24 * MiB, WS_WUP = 26 * MiB, WS_WDN = 37 * MiB;
constexpr size_t WS_R0 = 43 * MiB;
constexpr size_t WS_R1 = 75 * MiB;
constexpr size_t WS_U = 203 * MiB, WS_AQ = 235 * MiB;
constexpr size_t WS_ACT = 163 * MiB;
constexpr size_t WS_SSQP = 139 * MiB;
constexpr size_t WS_END = 256 * MiB;
constexpr int LDS_MISC = 147456, LDS_BYTES = 147456 + 256;
constexpr int CW_BAR = 1024;

__device__ __forceinline__ int tid_fresh() { int t = threadIdx.x; asm volatile("" : "+v"(t)); return t; }
#define LDS_WAIT() asm volatile("s_waitcnt lgkmcnt(0)" ::: "memory")
#define MFMA16(a, b, c) __builtin_amdgcn_mfma_f32_16x16x32_bf16((a), (b), (c), 0, 0, 0)
__device__ __forceinline__ float wave_sum(float v) {
#pragma unroll
    for (int o = 1; o < 64; o <<= 1) v += __shfl_xor(v, o);
    return v;
}
__device__ __forceinline__ float silu_f(float x) { return x * __builtin_amdgcn_rcpf(1.0f + __expf(-x)); }
__device__ __forceinline__ bf16x8 pack8(const float (&y)[8]) { u32x4 w; w.x = cvt_pk_bf16(y[0], y[1]); w.y = cvt_pk_bf16(y[2], y[3]); w.z = cvt_pk_bf16(y[4], y[5]); w.w = cvt_pk_bf16(y[6], y[7]); return __builtin_bit_cast(bf16x8, w); }
__device__ __forceinline__ bf16x8 pack44(const f32x4 a, const f32x4 b) { u32x4 w; w.x = cvt_pk_bf16(a[0], a[1]); w.y = cvt_pk_bf16(a[2], a[3]); w.z = cvt_pk_bf16(b[0], b[1]); w.w = cvt_pk_bf16(b[2], b[3]); return __builtin_bit_cast(bf16x8, w); }

#define XB_TMO      128
#define XB_XCNT(j)  (256  + 64 * (j))
#define XB_XSUB(j)  (1280 + 64 * (j))
#define XB_XGEN(j)  (2304 + 64 * (j))
#define XB_TOP      3328
#define XB_TOPGEN   3392
#define XCD_BAR_WORDS 3456
#define XB_SPIN_CAP (1u << 18)

__device__ __forceinline__ unsigned xb_ld(unsigned* p)              { return __hip_atomic_load(p, __ATOMIC_RELAXED, __HIP_MEMORY_SCOPE_AGENT); }
__device__ __forceinline__ unsigned xb_add(unsigned* p, unsigned v) { return __hip_atomic_fetch_add(p, v, __ATOMIC_RELAXED, __HIP_MEMORY_SCOPE_AGENT); }
__device__ __forceinline__ unsigned xb_xcc_id() { return (unsigned)__builtin_amdgcn_s_getreg((3 << 11) | 20) & 0xFu; }
#define XB_SPIN(cond, bar) do { unsigned _sp = 0; while (cond) { __builtin_amdgcn_s_sleep(1); \
    if ((++_sp & 255u) == 0u) { if (xb_ld(&(bar)[XB_TMO])) break; if (_sp > XB_SPIN_CAP) { atomicAdd(&(bar)[XB_TMO], 1u); break; } } } } while (0)

struct XcdBarrier {
    unsigned* bar; unsigned x;
    volatile LAS unsigned* st;
};

__device__ __forceinline__ XcdBarrier xcd_barrier_post(unsigned* bar, volatile LAS unsigned* st) {
    XcdBarrier b; b.bar = bar; b.x = xb_xcc_id(); b.st = st;
    if (threadIdx.x == 0) (void)xb_add(&bar[XB_XCNT(b.x)], 1u);
    return b;
}
__device__ __forceinline__ void xcd_barrier_complete(unsigned* bar, unsigned x, unsigned& nloc, unsigned& nx) {
    const unsigned G = gridDim.x * gridDim.y * gridDim.z;
    unsigned sum, cnt, mine, sp = 0u;
    for (;;) {
        sum = 0u; cnt = 0u; mine = 0u;
#pragma unroll
        for (unsigned j = 0; j < 16; ++j) { const unsigned c = xb_ld(&bar[XB_XCNT(j)]); sum += c; cnt += (c > 0u) ? 1u : 0u; mine = (j == x) ? c : mine; }
        if (sum == G) break;
        __builtin_amdgcn_s_sleep(1);
        if ((++sp & 255u) == 0u) { if (xb_ld(&bar[XB_TMO])) break; if (sp > XB_SPIN_CAP) { atomicAdd(&bar[XB_TMO], 1u); break; } }
    }
    nloc = mine > 0u ? mine : 1u; nx = cnt > 0u ? cnt : 1u;
}

__device__ __forceinline__ void xcd_barrier(const XcdBarrier& b) {
    asm volatile("s_waitcnt vmcnt(0)" ::: "memory");
    __syncthreads();
    if (threadIdx.x == 0) {
        unsigned* bar = b.bar;
        __builtin_amdgcn_s_waitcnt(0);
        unsigned nloc = b.st[0], nx = b.st[1];
        if (nloc == 0u) { xcd_barrier_complete(bar, b.x, nloc, nx); b.st[0] = nloc; b.st[1] = nx; }
        const unsigned old = xb_add(&bar[XB_XSUB(b.x)], 1u);
        const unsigned gen = old / nloc;
        if (old + 1u == (gen + 1u) * nloc) {
            __builtin_amdgcn_fence(__ATOMIC_RELEASE, "agent");
            asm volatile("s_waitcnt vmcnt(0)" ::: "memory");
            const unsigned og = xb_add(&bar[XB_TOP], 1u);
            const unsigned tg = og / nx;
            if (og + 1u == (tg + 1u) * nx) xb_add(&bar[XB_TOPGEN], 1u);
            else XB_SPIN(xb_ld(&bar[XB_TOPGEN]) == tg, bar);
            __builtin_amdgcn_fence(__ATOMIC_ACQUIRE, "agent");
            xb_add(&bar[XB_XGEN(b.x)], 1u);
            asm volatile("s_waitcnt vmcnt(0)" ::: "memory");
        } else {
            XB_SPIN(xb_ld(&bar[XB_XGEN(b.x)]) == gen, bar);
            __builtin_amdgcn_fence(__ATOMIC_ACQUIRE, "agent");
            asm volatile("s_waitcnt vmcnt(0)" ::: "memory");
        }
    }
    __syncthreads();
}

__device__ __forceinline__ void transpose_item(const float* W, int ldw, int K, int ncols, bf16* WT, int row_off, LAS float* scr, int item, int lane, const float* kscale = nullptr) {
    const int nblk = ncols / 32, kb = item / nblk, nb = item % nblk, k0 = 64 * kb, n0 = 32 * nb;
    f32x4 v[8];
#pragma unroll
    for (int i = 0; i < 8; ++i) v[i] = *(const f32x4*)(W + (size_t)(k0 + 8 * i + (lane >> 3)) * ldw + n0 + 4 * (lane & 7));
#pragma unroll
    for (int i = 0; i < 8; ++i) { LAS float* p = scr + (8 * i + (lane >> 3)) * 33 + 4 * (lane & 7); const float ksc = kscale ? kscale[k0 + 8 * i + (lane >> 3)] : 1.0f; p[0] = v[i].x * ksc; p[1] = v[i].y * ksc; p[2] = v[i].z * ksc; p[3] = v[i].w * ksc; }
    LDS_WAIT();
    const int c = lane & 7;
#pragma unroll
    for (int j = 0; j < 4; ++j) { const int n = (lane >> 3) + 8 * j; const LAS float* s = scr + (8 * c) * 33 + n;
        u32x4 o; o.x = cvt_pk_bf16(s[0 * 33], s[1 * 33]); o.y = cvt_pk_bf16(s[2 * 33], s[3 * 33]); o.z = cvt_pk_bf16(s[4 * 33], s[5 * 33]); o.w = cvt_pk_bf16(s[6 * 33], s[7 * 33]);
        *(u32x4*)(WT + (size_t)(row_off + n0 + n) * K + k0 + 8 * c) = o; }
    LDS_WAIT();
}
__device__ __forceinline__ void phase_weights(LAS unsigned char* lds, const float* w_in, const float* w_a, const float* w_b, const float* w_o, const float* w_up, const float* w_dn, const float* g_ffn, unsigned char* ws, int part, int wg, int nwg) {
    const int lane = tid_fresh() & 63, wave = __builtin_amdgcn_readfirstlane(tid_fresh() >> 6);
    LAS float* scr = (LAS float*)(lds + wave * 8448);
    const int gw = wg * NWAVES + wave, NGW = nwg * NWAVES;
    constexpr int I0 = 16 * 128, I1 = 16 * 96, I2 = 16 * 64, I3 = 16 * 32, I4 = 16 * 176, I5 = 44 * 32;
    constexpr int NITEMS = I0 + I1 + I2 + 3 * I3 + I4 + I5;
    bf16* win = (bf16*)(ws + WS_WIN);
    constexpr int ISPLIT = I0 + I1 + I2;
    for (int it = (part == 1 ? ISPLIT : 0) + gw; it < (part == 0 ? ISPLIT : NITEMS); it += NGW) {
        int r = it;
        if (r < I0) { transpose_item(w_in + 3072, INW, D, 4096, win, 0, scr, r, lane); continue; } r -= I0;
        if (r < I1) { transpose_item(w_in, INW, D, 3072, win, 4096, scr, r, lane); continue; } r -= I1;
        if (r < I2) { transpose_item(w_in + 7184, INW, D, 2048, win, 7168, scr, r, lane); continue; } r -= I2;
        if (r < I3) { transpose_item(w_a, D, D, D, (bf16*)(ws + WS_WA), 0, scr, r, lane); continue; } r -= I3;
        if (r < I3) { transpose_item(w_b, D, D, D, (bf16*)(ws + WS_WB), 0, scr, r, lane); continue; } r -= I3;
        if (r < I3) { transpose_item(w_o, D, D, D, (bf16*)(ws + WS_WO), 0, scr, r, lane); continue; } r -= I3;
        if (r < I4) { const int n0 = 32 * (r % 176), j = (n0 < FF) ? n0 : n0 - FF, dst0 = (j / 128) * 256 + (j % 128) + ((n0 < FF) ? 0 : 128);
            transpose_item(w_up, 2 * FF, D, 2 * FF, (bf16*)(ws + WS_WUP), dst0 - n0, scr, r, lane, g_ffn); continue; } r -= I4;
        transpose_item(w_dn, D, FF, D, (bf16*)(ws + WS_WDN), 0, scr, r, lane);
    }
}
template <int MODE>
__device__ __forceinline__ void phase_norm(LAS unsigned char* lds, const float* x, const float* g, bf16* ob, float* of, const float* w_in, const float* A_log, const float* dt_bias, float* gtab, float* btab) {
    const int tid = tid_fresh(), lane = tid & 63, wave = __builtin_amdgcn_readfirstlane(tid >> 6);
    LAS float* slab = (LAS float*)lds;
    if (MODE == 1) {
        for (int i = tid; i < 4096; i += NWAVES * 64) { const int k = i >> 2, c4 = i & 3; const int p = ((k >> 8) * 4 + (k & 3)) * 64 + ((k >> 2) & 63);
            const f32x4 v = *(const f32x4*)(w_in + (size_t)k * INW + 7168 + 4 * c4); *(LAS f32x4*)(slab + p * 20 + 4 * c4) = v; }
        __syncthreads();
    }
    f32x4 gv[4];
#pragma unroll
    for (int j = 0; j < 4; ++j) gv[j] = *((const f32x4*)g + lane + 64 * j);
    const int gw = blockIdx.x * NWAVES + wave, NGW = gridDim.x * NWAVES;
    f32x4 cur[2][4], nxt[2][4];
#pragma unroll
    for (int rr = 0; rr < 2; ++rr)
#pragma unroll
        for (int j = 0; j < 4; ++j) { const int m = gw + rr * NGW; cur[rr][j] = (m < M) ? *((const f32x4*)(x + (size_t)m * D) + lane + 64 * j) : (f32x4){0.f, 0.f, 0.f, 0.f}; }
    for (int m0 = gw; m0 < M; m0 += 2 * NGW) {
#pragma unroll
        for (int rr = 0; rr < 2; ++rr)
#pragma unroll
            for (int j = 0; j < 4; ++j) { const int m = m0 + (2 + rr) * NGW; nxt[rr][j] = (m < M) ? *((const f32x4*)(x + (size_t)m * D) + lane + 64 * j) : (f32x4){0.f, 0.f, 0.f, 0.f}; }
#pragma unroll
        for (int rr = 0; rr < 2; ++rr) {
            const int m = m0 + rr * NGW;
            if (m < M) {
                f32x4 v[4]; float s = 0.f;
#pragma unroll
                for (int j = 0; j < 4; ++j) { v[j] = cur[rr][j]; s += (v[j].x * v[j].x + v[j].y * v[j].y) + (v[j].z * v[j].z + v[j].w * v[j].w); }
                const float rstd = rsqrtf(wave_sum(s) * (1.f / D) + EPS);
#pragma unroll
                for (int j = 0; j < 4; ++j) v[j] = v[j] * rstd * gv[j];
                if (MODE == 2) {
                    f32x4* o = (f32x4*)(of + (size_t)m * D) + lane;
#pragma unroll
                    for (int j = 0; j < 4; ++j) o[64 * j] = v[j];
                } else {
                    u32x2* o = (u32x2*)(ob + (size_t)m * D) + lane;
#pragma unroll
                    for (int j = 0; j < 4; ++j) { u32x2 w; w.x = cvt_pk_bf16(v[j].x, v[j].y); w.y = cvt_pk_bf16(v[j].z, v[j].w); o[64 * j] = w; }
                }
                if (MODE == 1) {
                    float acc[16];
#pragma unroll
                    for (int c = 0; c < 16; ++c) acc[c] = 0.f;
#pragma unroll
                    for (int j = 0; j < 4; ++j)
#pragma unroll
                        for (int i = 0; i < 4; ++i) { const float hv = v[j][i]; const LAS f32x4* wp = (const LAS f32x4*)(slab + ((j * 4 + i) * 64 + lane) * 20);
#pragma unroll
                            for (int c4 = 0; c4 < 4; ++c4) { const f32x4 w = wp[c4]; acc[4 * c4 + 0] += hv * w.x; acc[4 * c4 + 1] += hv * w.y; acc[4 * c4 + 2] += hv * w.z; acc[4 * c4 + 3] += hv * w.w; } }
                    float r8[8], r4[4], r2[2], r1;
                    { const bool up = (lane & 32) != 0;
#pragma unroll
                      for (int c = 0; c < 8; ++c) { const float keep = up ? acc[8 + c] : acc[c], send = up ? acc[c] : acc[8 + c]; r8[c] = keep + __shfl_xor(send, 32); } }
                    { const bool up = (lane & 16) != 0;
#pragma unroll
                      for (int c = 0; c < 4; ++c) { const float keep = up ? r8[4 + c] : r8[c], send = up ? r8[c] : r8[4 + c]; r4[c] = keep + __shfl_xor(send, 16); } }
                    { const bool up = (lane & 8) != 0;
#pragma unroll
                      for (int c = 0; c < 2; ++c) { const float keep = up ? r4[2 + c] : r4[c], send = up ? r4[c] : r4[2 + c]; r2[c] = keep + __shfl_xor(send, 8); } }
                    { const bool up = (lane & 4) != 0; const float keep = up ? r2[1] : r2[0], send = up ? r2[0] : r2[1]; r1 = keep + __shfl_xor(send, 4); }
                    r1 += __shfl_xor(r1, 2); r1 += __shfl_xor(r1, 1);
                    const int cidx = ((lane >> 5) & 1) * 8 + ((lane >> 4) & 1) * 4 + ((lane >> 3) & 1) * 2 + ((lane >> 2) & 1);
                    if ((lane & 3) == 0) {
                        if (cidx < 8) { const float xx = r1 + dt_bias[cidx]; const float sp = (xx > 20.f) ? xx : log1pf(__expf(xx)); gtab[(size_t)m * 8 + cidx] = -__expf(A_log[cidx]) * sp; }
                        else btab[(size_t)m * 8 + cidx - 8] = sigm(r1);
                    }
                }
            }
        }
#pragma unroll
        for (int rr = 0; rr < 2; ++rr)
#pragma unroll
            for (int j = 0; j < 4; ++j) cur[rr][j] = nxt[rr][j];
    }
}
__device__ __forceinline__ void phase_convA(const bf16* BG, const bf16* CG, const bf16* XV, const float* cw, bf16* CA) {
    const int gt = blockIdx.x * (NWAVES * 64) + tid_fresh(), NT = gridDim.x * NWAVES * 64;
    for (int idx = gt; idx < (M / 8) * 128; idx += NT) {
        const int r0 = (idx >> 7) * 8, c = (idx & 127) * 8, tb0 = r0 & (SEQ - 1);
        u32x4 a[10], b[10], g[8];
#pragma unroll
        for (int i = 0; i < 10; ++i) { const int rr = r0 - 2 + i; if (tb0 - 2 + i >= 0) { a[i] = *(const u32x4*)(CG + (size_t)rr * D + c); b[i] = *(const u32x4*)(XV + (size_t)rr * D + c); } else { a[i] = (u32x4){0u, 0u, 0u, 0u}; b[i] = a[i]; } }
#pragma unroll
        for (int i = 0; i < 8; ++i) g[i] = *(const u32x4*)(BG + (size_t)(r0 + i) * D + c);
        f32x4 w[3][2];
#pragma unroll
        for (int j = 0; j < 3; ++j) { w[j][0] = *(const f32x4*)(cw + j * D + c); w[j][1] = *(const f32x4*)(cw + j * D + c + 4); }
        float p[10][8];
#pragma unroll
        for (int i = 0; i < 10; ++i) { p[i][0] = bflo(a[i].x) * bflo(b[i].x); p[i][1] = bfhi(a[i].x) * bfhi(b[i].x); p[i][2] = bflo(a[i].y) * bflo(b[i].y); p[i][3] = bfhi(a[i].y) * bfhi(b[i].y);
            p[i][4] = bflo(a[i].z) * bflo(b[i].z); p[i][5] = bfhi(a[i].z) * bfhi(b[i].z); p[i][6] = bflo(a[i].w) * bflo(b[i].w); p[i][7] = bfhi(a[i].w) * bfhi(b[i].w); }
#pragma unroll
        for (int i = 0; i < 8; ++i) { float o[8];
#pragma unroll
            for (int k = 0; k < 8; ++k) o[k] = w[0][k >> 2][k & 3] * p[i][k] + w[1][k >> 2][k & 3] * p[i + 1][k] + w[2][k >> 2][k & 3] * p[i + 2][k];
            u32x4 ww; ww.x = cvt_pk_bf16(o[0] * bflo(g[i].x), o[1] * bfhi(g[i].x)); ww.y = cvt_pk_bf16(o[2] * bflo(g[i].y), o[3] * bfhi(g[i].y));
            ww.z = cvt_pk_bf16(o[4] * bflo(g[i].z), o[5] * bfhi(g[i].z)); ww.w = cvt_pk_bf16(o[6] * bflo(g[i].w), o[7] * bfhi(g[i].w));
            *(u32x4*)(CA + (size_t)(r0 + i) * D + c) = ww; }
    }
}
__device__ __forceinline__ void phase_act(const bf16* UP, const float* cw, bf16* ACT) {
    const int gt = blockIdx.x * (NWAVES * 64) + tid_fresh(), NT = gridDim.x * NWAVES * 64;
    constexpr int CG8 = FF / 8;
    for (int idx = gt; idx < (SEQ / 8) * CG8; idx += NT) {
        const int r0 = (idx / CG8) * 8, c = (idx % CG8) * 8;
        u32x4 a[10], b[10];
#pragma unroll
        for (int i = 0; i < 10; ++i) { const int rr = r0 - 2 + i; if (rr >= 0) { a[i] = *(const u32x4*)(UP + (size_t)rr * (2 * FF) + c); b[i] = *(const u32x4*)(UP + (size_t)rr * (2 * FF) + FF + c); } else { a[i] = (u32x4){0u, 0u, 0u, 0u}; b[i] = a[i]; } }
        f32x4 wg[3][2], wv[3][2];
#pragma unroll
        for (int j = 0; j < 3; ++j) { wg[j][0] = *(const f32x4*)(cw + j * 2 * FF + c); wg[j][1] = *(const f32x4*)(cw + j * 2 * FF + c + 4); wv[j][0] = *(const f32x4*)(cw + j * 2 * FF + FF + c); wv[j][1] = *(const f32x4*)(cw + j * 2 * FF + FF + c + 4); }
#pragma unroll
        for (int i = 0; i < 8; ++i) { float o[8];
#pragma unroll
            for (int k = 0; k < 8; ++k) {
                float ag = 0.f, av = 0.f;
#pragma unroll
                for (int j = 0; j < 3; ++j) { const unsigned ua = ((const unsigned*)&a[i + j])[k >> 1], ub = ((const unsigned*)&b[i + j])[k >> 1];
                    ag += wg[j][k >> 2][k & 3] * ((k & 1) ? bfhi(ua) : bflo(ua)); av += wv[j][k >> 2][k & 3] * ((k & 1) ? bfhi(ub) : bflo(ub)); }
                o[k] = silu_f(ag) * av; }
            u32x4 ww; ww.x = cvt_pk_bf16(o[0], o[1]); ww.y = cvt_pk_bf16(o[2], o[3]); ww.z = cvt_pk_bf16(o[4], o[5]); ww.w = cvt_pk_bf16(o[6], o[7]);
            *(u32x4*)(ACT + (size_t)(r0 + i) * FF + c) = ww; }
    }
}

struct G1Regs { u32x4 d[9]; f32x4 w[2]; };
__device__ __forceinline__ void g1_issue(G1Regs& g, const bf16* src, const float* cw, int row0, int tb0, int hf, int lane) {
#pragma unroll
    for (int i = 0; i < 9; ++i) { const int p = lane + 64 * i; g.d[i] = (u32x4){0u, 0u, 0u, 0u};
        if (p < 560) { const int lr = p >> 4, cp = p & 15, tok = 32 * hf - 3 + lr; if (tb0 + tok >= 0) g.d[i] = *(const u32x4*)(src + (size_t)(row0 + tok) * D + cp * 8); } }
#pragma unroll
    for (int i = 0; i < 2; ++i) { const int p = lane + 64 * i; g.w[i] = *(const f32x4*)(cw + (p >> 5) * 3072 + (p & 31) * 4); }
}
template <int NORM, int FACT, bool QDOUT>
__device__ __forceinline__ void g1_consume(LAS unsigned char* R, const LAS float* tab, const G1Regs& g, int hf, int lane, int r, int q, bf16x8 (&f)[4][4], u32x4* qd, u32x4* aq) {
    LAS unsigned char* Wl = R + 9520;
#pragma unroll
    for (int i = 0; i < 2; ++i) *(LAS f32x4*)(Wl + (lane + 64 * i) * 16) = g.w[i];
#pragma unroll
    for (int i = 0; i < 9; ++i) { const int p = lane + 64 * i; if (p < 560) *(LAS u32x4*)(R + (p >> 4) * 272 + (p & 15) * 16) = g.d[i]; }
    LDS_WAIT();
#pragma unroll
    for (int m2 = 0; m2 < 2; ++m2) {
        const int mi = 2 * hf + m2; float y[4][8]; float ssq = 0.f;
#pragma unroll
        for (int ks = 0; ks < 4; ++ks) {
            const int c0 = 32 * ks + 4 * q;
#pragma unroll
            for (int i = 0; i < 8; ++i) y[ks][i] = 0.f;
#pragma unroll
            for (int j = 0; j < 4; ++j) { const LAS unsigned char* p = R + (16 * m2 + r + j) * 272 + c0 * 2; const u32x2 a = *(const LAS u32x2*)p, b = *(const LAS u32x2*)(p + 32);
                const f32x4 w0 = *(const LAS f32x4*)(Wl + (j * 128 + c0) * 4), w1 = *(const LAS f32x4*)(Wl + (j * 128 + c0 + 16) * 4);
                y[ks][0] += w0.x * bflo(a.x); y[ks][1] += w0.y * bfhi(a.x); y[ks][2] += w0.z * bflo(a.y); y[ks][3] += w0.w * bfhi(a.y);
                y[ks][4] += w1.x * bflo(b.x); y[ks][5] += w1.y * bfhi(b.x); y[ks][6] += w1.z * bflo(b.y); y[ks][7] += w1.w * bfhi(b.y); }
#pragma unroll
            for (int i = 0; i < 8; ++i) { y[ks][i] = silu_f(y[ks][i]); ssq += y[ks][i] * y[ks][i]; }
        }
        float sc = 1.f;
        if (NORM) { ssq += __shfl_xor(ssq, 16); ssq += __shfl_xor(ssq, 32); sc = rsqrtf(ssq + EPS) * (NORM == 2 ? 0.08838834764831845f : 1.0f); }
        if (FACT >= 0) sc *= tab[(FACT >= 0 ? FACT : 0) + 16 * mi + r];
        bf16x8 qrow[4];
#pragma unroll
        for (int ks = 0; ks < 4; ++ks) {
#pragma unroll
            for (int i = 0; i < 8; ++i) y[ks][i] *= sc;
            if (!QDOUT) f[mi][ks] = pack8(y[ks]);
            else { qrow[ks] = pack8(y[ks]); const float e1 = tab[128 + 16 * mi + r];
#pragma unroll
                for (int i = 0; i < 8; ++i) y[ks][i] *= e1;
                qd[(mi * 4 + ks) * 64 + lane] = __builtin_bit_cast(u32x4, pack8(y[ks])); }
        }
        if (QDOUT) {
#pragma unroll
            for (int s = 0; s < 2; ++s) {
                f32x4 d0 = {0.f, 0.f, 0.f, 0.f}, d1 = {0.f, 0.f, 0.f, 0.f};
                if (2 * s <= mi) {
#pragma unroll
                    for (int ks = 0; ks < 4; ++ks) d0 = MFMA16(f[2 * s][ks], qrow[ks], d0); }
                if (2 * s + 1 <= mi) {
#pragma unroll
                    for (int ks = 0; ks < 4; ++ks) d1 = MFMA16(f[2 * s + 1][ks], qrow[ks], d1); }
                const int ip = 16 * mi + r; const float Gq = tab[ip];
                const int i0 = 32 * s + 4 * q, i1 = i0 + 16; const f32x4 G0 = *(const LAS f32x4*)(tab + i0), G1 = *(const LAS f32x4*)(tab + i1);
#pragma unroll
                for (int e = 0; e < 4; ++e) { d0[e] = (i0 + e <= ip) ? d0[e] * __expf(Gq - G0[e]) : 0.f; d1[e] = (i1 + e <= ip) ? d1[e] * __expf(Gq - G1[e]) : 0.f; }
                aq[(mi * 2 + s) * 64 + lane] = __builtin_bit_cast(u32x4, pack44(d0, d1));
            }
        }
    }
    LDS_WAIT();
}
__device__ __forceinline__ void phase_g1(LAS unsigned char* lds, const bf16* Pq, const bf16* Pk, const bf16* Pv, const float* cw, const float* gtab, const float* btab,
                                         float* Elast, u32x4* NW, u32x4* QD, u32x4* KT, u32x4* AQ, u32x2* U) {
    const int lane0 = tid_fresh() & 63, wave = __builtin_amdgcn_readfirstlane(tid_fresh() >> 6);
    for (int chunk = blockIdx.x * NWAVES + wave; chunk < NCHUNK; chunk += gridDim.x * NWAVES) {
        int lane = lane0; asm volatile("" : "+v"(lane));
        const int r = lane & 15, q = lane >> 4;
        LAS unsigned char* R = lds + wave * 18432;
        LAS float* tab = (LAS float*)(R + 16896);
        const int bh = chunk >> 7, n = chunk & 127, b = bh >> 3, h = bh & 7, row0 = b * SEQ + n * 64, tb0 = n * 64, hc = h * 128;
        {   const float g = gtab[(size_t)(row0 + lane) * 8 + h], be = btab[(size_t)(row0 + lane) * 8 + h];
            float gc = g;
#pragma unroll
            for (int o = 1; o < 64; o <<= 1) { const float t = __shfl_up(gc, o); if (lane >= o) gc += t; }
            const float gl = __shfl(gc, 63);
            tab[lane] = gc; tab[64 + lane] = be; tab[128 + lane] = __expf(gc); tab[192 + lane] = __expf(gl - gc); tab[256 + lane] = be * __expf(gc);
            if (lane == 0) Elast[chunk] = __expf(gl); }
        LDS_WAIT();
        bf16x8 kf[4][4];
        G1Regs ga, gb;
        g1_issue(ga, Pk + hc, cw + 1024 + hc, row0, tb0, 0, lane);
        g1_issue(gb, Pk + hc, cw + 1024 + hc, row0, tb0, 1, lane);
        g1_consume<1, -1, false>(R, tab, ga, 0, lane, r, q, kf, nullptr, nullptr);
        g1_issue(ga, Pq + hc, cw + hc, row0, tb0, 0, lane);
        g1_consume<1, -1, false>(R, tab, gb, 1, lane, r, q, kf, nullptr, nullptr);
        g1_issue(gb, Pq + hc, cw + hc, row0, tb0, 1, lane);
        g1_consume<2, -1, true>(R, tab, ga, 0, lane, r, q, kf, QD + (size_t)chunk * 1024, AQ + (size_t)chunk * 512);
        g1_consume<2, -1, true>(R, tab, gb, 1, lane, r, q, kf, QD + (size_t)chunk * 1024, AQ + (size_t)chunk * 512);
        LAS float* L = (LAS float*)R;
#pragma unroll
        for (int mi = 0; mi < 4; ++mi)
#pragma unroll
            for (int mj = 0; mj <= mi; ++mj) {
                f32x4 acc = {0.f, 0.f, 0.f, 0.f};
#pragma unroll
                for (int ks = 0; ks < 4; ++ks) acc = MFMA16(kf[mj][ks], kf[mi][ks], acc);
                const int i = 16 * mi + r, j0 = 16 * mj + 4 * q; const float Gi = tab[i], bi = tab[64 + i]; const f32x4 Gj = *(const LAS f32x4*)(tab + j0);
                f32x4 o;
#pragma unroll
                for (int e = 0; e < 4; ++e) o[e] = (j0 + e < i) ? bi * acc[e] * __expf(Gi - Gj[e]) : 0.f;
                *(LAS f32x4*)(L + i * 64 + j0) = o;
            }
        LDS_WAIT();
        float Tc[64];
#pragma unroll
        for (int i = 0; i < 64; ++i) {
            float a0 = (lane == i) ? 1.f : 0.f, a1 = 0.f, a2 = 0.f, a3 = 0.f;
#pragma unroll
            for (int j4 = 0; j4 < i; j4 += 4) { const f32x4 l = *(const LAS f32x4*)(L + i * 64 + j4);
                a0 -= l[0] * Tc[j4];
                if (j4 + 1 < i) a1 -= l[1] * Tc[j4 + 1];
                if (j4 + 2 < i) a2 -= l[2] * Tc[j4 + 2];
                if (j4 + 3 < i) a3 -= l[3] * Tc[j4 + 3]; }
            Tc[i] = (a0 + a1) + (a2 + a3);
            __builtin_amdgcn_sched_barrier(0);
        }
        LDS_WAIT();
        { LAS unsigned short* Ti = (LAS unsigned short*)R;
#pragma unroll
          for (int i = 0; i < 64; ++i) Ti[i * 64 + lane] = (unsigned short)(cvt_pk_bf16(Tc[i], 0.f) & 0xffffu); }
        LDS_WAIT();
        bf16x8 Tf[4][2];
#pragma unroll
        for (int mi = 0; mi < 4; ++mi)
#pragma unroll
            for (int s = 0; s < 2; ++s) { const LAS unsigned char* p = R + ((16 * mi + r) * 64 + 32 * s + 4 * q) * 2; const u32x2 a = *(const LAS u32x2*)p, bb = *(const LAS u32x2*)(p + 32);
                u32x4 w; w.x = a.x; w.y = a.y; w.z = bb.x; w.w = bb.y; Tf[mi][s] = __builtin_bit_cast(bf16x8, w); }
        LDS_WAIT();
#pragma unroll
        for (int mi = 0; mi < 4; ++mi)
#pragma unroll
            for (int ks = 0; ks < 4; ++ks) { LAS unsigned char* p = R + (16 * mi + r) * 264 + (32 * ks + 4 * q) * 2; const u32x4 w = __builtin_bit_cast(u32x4, kf[mi][ks]);
                u32x2 lo; lo.x = w.x; lo.y = w.y; u32x2 hi; hi.x = w.z; hi.y = w.w; *(LAS u32x2*)p = lo; *(LAS u32x2*)(p + 32) = hi; }
        LDS_WAIT();
        {   float e2r[2][8], e3r[2][8];
#pragma unroll
            for (int s = 0; s < 2; ++s)
#pragma unroll
                for (int jj = 0; jj < 8; ++jj) { const int tok = 32 * s + 16 * (jj >> 2) + 4 * q + (jj & 3); e2r[s][jj] = tab[192 + tok]; e3r[s][jj] = tab[256 + tok]; }
#pragma unroll 1
            for (int ks = 0; ks < 4; ++ks) {
                bf16x8 kb[2][2];
#pragma unroll
                for (int t = 0; t < 2; ++t)
#pragma unroll
                    for (int s = 0; s < 2; ++s) { const int dj = 2 * ks + t; float kd[8], kg[8];
#pragma unroll
                        for (int jj = 0; jj < 8; ++jj) { const int tok = 32 * s + 16 * (jj >> 2) + 4 * q + (jj & 3);
                            const float f = __uint_as_float((unsigned)(*(const LAS unsigned short*)(R + tok * 264 + (16 * dj + r) * 2)) << 16); kd[jj] = f * e2r[s][jj]; kg[jj] = f * e3r[s][jj]; }
                        KT[(((size_t)chunk * 8 + dj) * 2 + s) * 64 + lane] = __builtin_bit_cast(u32x4, pack8(kd)); kb[t][s] = pack8(kg); }
#pragma unroll
                for (int mi = 0; mi < 4; ++mi) { f32x4 a0 = {0.f, 0.f, 0.f, 0.f}, a1 = {0.f, 0.f, 0.f, 0.f};
#pragma unroll
                    for (int s = 0; s < 2; ++s) { a0 = MFMA16(kb[0][s], Tf[mi][s], a0); a1 = MFMA16(kb[1][s], Tf[mi][s], a1); }
                    NW[(((size_t)chunk * 4 + mi) * 4 + ks) * 64 + lane] = __builtin_bit_cast(u32x4, pack44(-a0, -a1)); }
            } }
        LDS_WAIT();
        {   bf16x8 vf[4][4];
            g1_issue(ga, Pv + hc, cw + 2048 + hc, row0, tb0, 0, lane);
            g1_issue(gb, Pv + hc, cw + 2048 + hc, row0, tb0, 1, lane);
            g1_consume<0, 64, false>(R, tab, ga, 0, lane, r, q, vf, nullptr, nullptr);
            g1_consume<0, 64, false>(R, tab, gb, 1, lane, r, q, vf, nullptr, nullptr);
#pragma unroll
            for (int mi = 0; mi < 4; ++mi)
#pragma unroll
                for (int ks = 0; ks < 4; ++ks) { LAS unsigned char* p = R + (16 * mi + r) * 264 + (32 * ks + 4 * q) * 2; const u32x4 w = __builtin_bit_cast(u32x4, vf[mi][ks]);
                    u32x2 lo; lo.x = w.x; lo.y = w.y; u32x2 hi; hi.x = w.z; hi.y = w.w; *(LAS u32x2*)p = lo; *(LAS u32x2*)(p + 32) = hi; } }
        LDS_WAIT();
#pragma unroll 1
        for (int es = 0; es < 8; ++es) {
            bf16x8 vb[2];
#pragma unroll
            for (int s = 0; s < 2; ++s) { unsigned hw[8];
#pragma unroll
                for (int jj = 0; jj < 8; ++jj) { const int tok = 32 * s + 16 * (jj >> 2) + 4 * q + (jj & 3); hw[jj] = *(const LAS unsigned short*)(R + tok * 264 + (16 * es + r) * 2); }
                u32x4 w; w.x = hw[0] | (hw[1] << 16); w.y = hw[2] | (hw[3] << 16); w.z = hw[4] | (hw[5] << 16); w.w = hw[6] | (hw[7] << 16); vb[s] = __builtin_bit_cast(bf16x8, w); }
#pragma unroll
            for (int mi = 0; mi < 4; ++mi) { f32x4 a = {0.f, 0.f, 0.f, 0.f};
#pragma unroll
                for (int s = 0; s < 2; ++s) a = MFMA16(Tf[mi][s], vb[s], a);
                settle(a);
                u32x2 w; w.x = cvt_pk_bf16(a[0], a[1]); w.y = cvt_pk_bf16(a[2], a[3]); U[(((size_t)chunk * 8 + es) * 4 + mi) * 64 + lane] = w; }
        }
        LDS_WAIT();
    }
}
constexpr int SCAN_NS = 1, SCAN_G = 8 / SCAN_NS, SCAN_WGS = 128 / SCAN_NS;
constexpr int SCAN_REC = 32768 + 2048 + 256;
__device__ __forceinline__ void settle4(f32x4& a, f32x4& b, f32x4& c, f32x4& d) { asm volatile("s_nop 15\n\ts_nop 3" : "+v"(a), "+v"(b), "+v"(c), "+v"(d)); }
__device__ __forceinline__ void phase_scan(LAS unsigned char* lds, const u32x4* NW, const u32x4* KT, const u32x2* U, const float* Elast, u32x4* SC, u32x4* VC) {
    if (blockIdx.x >= SCAN_WGS) return;
    const int tid = tid_fresh(), lane = tid & 63, wave = __builtin_amdgcn_readfirstlane(tid >> 6);
    const int xcd = blockIdx.x & 7, kk = blockIdx.x >> 3, bh = xcd * 2 + kk / SCAN_G, es = (kk % SCAN_G) * SCAN_NS + (wave & (SCAN_NS - 1)), chunk0 = bh * 128;
    const bool loader = wave >= 4, comp = wave < SCAN_NS;
    const int lt = tid & 255;
#define SCAN_BAR() do { asm volatile("s_waitcnt lgkmcnt(0)" ::: "memory"); __builtin_amdgcn_s_barrier(); asm volatile("" ::: "memory"); } while (0)
    if (loader) {
        u32x4 RQ[6][9]; float RE[6];
        const int es0 = (kk % SCAN_G) * SCAN_NS;
#define SCAN_GLD4(dst, p) asm volatile("global_load_dwordx4 %0, %1, off" : "=v"(dst) : "v"(p) : "memory")
#define SCAN_GLD1(dst, p) asm volatile("global_load_dword %0, %1, off" : "=v"(dst) : "v"(p) : "memory")
#define SCAN_LOAD(RR, EE, ch) do { const int c_ = (ch) < chunk0 + 127 ? (ch) : chunk0 + 127; _Pragma("unroll") for (int _i = 0; _i < 4; ++_i) { SCAN_GLD4(RR[_i], NW + (size_t)c_ * 1024 + _i * 256 + lt); SCAN_GLD4(RR[4 + _i], KT + (size_t)c_ * 1024 + _i * 256 + lt); } \
        SCAN_GLD4(RR[8], (const u32x4*)U + ((size_t)c_ * 8 + es0) * 128 + (lt & 127)); SCAN_GLD1(EE, Elast + c_); } while (0)
#define SCAN_PUT(RR, EE, boff) do { _Pragma("unroll") for (int _i = 0; _i < 8; ++_i) *(LAS u32x4*)(lds + (boff) + (_i * 256 + lt) * 16) = RR[_i]; \
        if (lt < 128) *(LAS u32x4*)(lds + (boff) + 32768 + lt * 16) = RR[8]; if (lt == 128) *(LAS float*)(lds + (boff) + 32768 + 2048) = EE; } while (0)
        SCAN_LOAD(RQ[0], RE[0], chunk0); SCAN_LOAD(RQ[1], RE[1], chunk0 + 1); SCAN_LOAD(RQ[2], RE[2], chunk0 + 2); SCAN_LOAD(RQ[3], RE[3], chunk0 + 3); SCAN_LOAD(RQ[4], RE[4], chunk0 + 4); SCAN_LOAD(RQ[5], RE[5], chunk0 + 5);
        asm volatile("s_waitcnt vmcnt(40)" ::: "memory"); SCAN_PUT(RQ[0], RE[0], 0); SCAN_PUT(RQ[1], RE[1], SCAN_REC);
        SCAN_LOAD(RQ[0], RE[0], chunk0 + 6); SCAN_LOAD(RQ[1], RE[1], chunk0 + 7);
        SCAN_BAR();
        int pb = 2 * SCAN_REC;
#define SCAN_LSTEP(n, j) do { if ((n) < 128) { asm volatile("s_waitcnt vmcnt(50)" ::: "memory"); SCAN_PUT(RQ[((j) + 2) % 6], RE[((j) + 2) % 6], pb); SCAN_LOAD(RQ[((j) + 2) % 6], RE[((j) + 2) % 6], chunk0 + (n) + 8); \
        pb = (pb == 2 * SCAN_REC) ? 0 : pb + SCAN_REC; SCAN_BAR(); } } while (0)
        for (int n = 0; n < 132; n += 6) { SCAN_LSTEP(n, 0); SCAN_LSTEP(n + 1, 1); SCAN_LSTEP(n + 2, 2); SCAN_LSTEP(n + 3, 3); SCAN_LSTEP(n + 4, 4); SCAN_LSTEP(n + 5, 5); }
        asm volatile("s_waitcnt vmcnt(0)" ::: "memory");
#undef SCAN_LSTEP
#undef SCAN_LOAD
#undef SCAN_PUT
#undef SCAN_GLD4
#undef SCAN_GLD1
    } else if (comp) {
        SCAN_BAR();
        f32x4 S[8];
#pragma unroll
        for (int di = 0; di < 8; ++di) S[di] = (f32x4){0.f, 0.f, 0.f, 0.f};
        bf16x8 af[16];
#pragma unroll
        for (int i = 0; i < 16; ++i) af[i] = *(const LAS bf16x8*)(lds + (i * 64 + lane) * 16);
        int cb = 0;
        for (int n = 0; n < 128; ++n) {
            const int chunk = chunk0 + n; const LAS unsigned char* base = lds + cb; const int nb = (cb == 2 * SCAN_REC) ? 0 : cb + SCAN_REC;
            bf16x8 kf[16];
#pragma unroll
            for (int i = 0; i < 16; ++i) kf[i] = *(const LAS bf16x8*)(base + 16384 + (i * 64 + lane) * 16);
            u32x2 uc[4];
#pragma unroll
            for (int mi = 0; mi < 4; ++mi) uc[mi] = *(const LAS u32x2*)(base + 32768 + (mi * 64 + lane) * 8);
            const float e = *(const LAS float*)(base + 32768 + 2048);
            __builtin_amdgcn_sched_barrier(0);
            bf16x8 Sfr[4];
#pragma unroll
            for (int ks = 0; ks < 4; ++ks) { Sfr[ks] = pack44(S[2 * ks], S[2 * ks + 1]); SC[(((size_t)chunk * 8 + es) * 4 + ks) * 64 + lane] = __builtin_bit_cast(u32x4, Sfr[ks]); }
            f32x4 vn[4];
#pragma unroll
            for (int mi = 0; mi < 4; ++mi) { vn[mi][0] = bflo(uc[mi].x); vn[mi][1] = bfhi(uc[mi].x); vn[mi][2] = bflo(uc[mi].y); vn[mi][3] = bfhi(uc[mi].y); }
#pragma unroll
            for (int ks = 0; ks < 4; ++ks)
#pragma unroll
                for (int mi = 0; mi < 4; ++mi) vn[mi] = MFMA16(af[mi * 4 + ks], Sfr[ks], vn[mi]);
            __builtin_amdgcn_sched_barrier(0);
            if (n + 1 < 128) {
#pragma unroll
                for (int i = 0; i < 16; ++i) af[i] = *(const LAS bf16x8*)(lds + nb + (i * 64 + lane) * 16); }
            settle4(vn[0], vn[1], vn[2], vn[3]);
            bf16x8 Vfr[2];
#pragma unroll
            for (int s = 0; s < 2; ++s) { Vfr[s] = pack44(vn[2 * s], vn[2 * s + 1]); VC[(((size_t)chunk * 8 + es) * 2 + s) * 64 + lane] = __builtin_bit_cast(u32x4, Vfr[s]); }
#pragma unroll
            for (int di = 0; di < 8; ++di) S[di] = S[di] * e;
#pragma unroll
            for (int s = 0; s < 2; ++s)
#pragma unroll
                for (int di = 0; di < 8; ++di) S[di] = MFMA16(kf[di * 2 + s], Vfr[s], S[di]);
            cb = nb;
            SCAN_BAR();
        }
    } else {
        for (int n = 0; n < 129; ++n) SCAN_BAR();
    }
#undef SCAN_BAR
}
__device__ __forceinline__ void phase_gout(const u32x4* QD, const u32x4* AQ, const u32x4* SC, const u32x4* VC, const bf16* Z, const float* ng, bf16* OB) {
    const int lane0 = tid_fresh() & 63, wave = __builtin_amdgcn_readfirstlane(tid_fresh() >> 6);
    for (int chunk = blockIdx.x * NWAVES + wave; chunk < NCHUNK; chunk += gridDim.x * NWAVES) {
        int lane = lane0; asm volatile("" : "+v"(lane)); const int c = lane & 15, q = lane >> 4;
        const int bh = chunk >> 7, n = chunk & 127, b = bh >> 3, h = bh & 7, row0 = b * SEQ + n * 64;
#pragma unroll 1
        for (int mp = 0; mp < 2; ++mp) {
            bf16x8 qa[2][4], aa[2][2];
#pragma unroll
            for (int m2 = 0; m2 < 2; ++m2) {
#pragma unroll
                for (int ks = 0; ks < 4; ++ks) qa[m2][ks] = __builtin_bit_cast(bf16x8, QD[(((size_t)chunk * 4 + 2 * mp + m2) * 4 + ks) * 64 + lane]);
#pragma unroll
                for (int s = 0; s < 2; ++s) aa[m2][s] = __builtin_bit_cast(bf16x8, AQ[(((size_t)chunk * 4 + 2 * mp + m2) * 2 + s) * 64 + lane]); }
            f32x4 o[2][8];
#pragma unroll
            for (int es = 0; es < 8; ++es) {
                bf16x8 sb[4], vb[2];
#pragma unroll
                for (int ks = 0; ks < 4; ++ks) sb[ks] = __builtin_bit_cast(bf16x8, SC[(((size_t)chunk * 8 + es) * 4 + ks) * 64 + lane]);
#pragma unroll
                for (int s = 0; s < 2; ++s) vb[s] = __builtin_bit_cast(bf16x8, VC[(((size_t)chunk * 8 + es) * 2 + s) * 64 + lane]);
#pragma unroll
                for (int m2 = 0; m2 < 2; ++m2) { f32x4 a = {0.f, 0.f, 0.f, 0.f};
#pragma unroll
                    for (int ks = 0; ks < 4; ++ks) a = MFMA16(sb[ks], qa[m2][ks], a);
#pragma unroll
                    for (int s = 0; s < 2; ++s) a = MFMA16(vb[s], aa[m2][s], a);
                    o[m2][es] = a; }
            }
#pragma unroll
            for (int m2 = 0; m2 < 2; ++m2) {
                float ss = 0.f;
#pragma unroll
                for (int es = 0; es < 8; ++es) { const f32x4 t = o[m2][es] * o[m2][es]; ss += (t[0] + t[1]) + (t[2] + t[3]); }
                ss += __shfl_xor(ss, 16); ss += __shfl_xor(ss, 32);
                const float rstd = rsqrtf(ss * (1.f / 128.f) + EPS);
                const size_t rowoff = (size_t)(row0 + 16 * (2 * mp + m2) + c) * D + h * 128 + 4 * q;
#pragma unroll
                for (int es = 0; es < 8; ++es) { const f32x4 gc = *(const f32x4*)(ng + 16 * es + 4 * q); const u32x2 zz = *(const u32x2*)(Z + rowoff + 16 * es);
                    const f32x4 v = o[m2][es] * rstd * gc;
                    u32x2 w; w.x = cvt_pk_bf16(v[0] * silu_f(bflo(zz.x)), v[1] * silu_f(bfhi(zz.x))); w.y = cvt_pk_bf16(v[2] * silu_f(bflo(zz.y)), v[3] * silu_f(bfhi(zz.y)));
                    *(u32x2*)(OB + rowoff + 16 * es) = w; }
            }
        }
    }
}

struct Args { const float* in[16]; float* out; unsigned char* ws; };
#ifndef USE_CG_ALL
#define USE_CG_ALL 0
#endif
__global__ void __launch_bounds__(NWAVES * 64, 2) fwd_megakernel(Args args) {
    extern __shared__ __attribute__((aligned(16))) unsigned char lds_raw[];
    LAS unsigned char* lds = (LAS unsigned char*)lds_raw;
    cg::grid_group grid = cg::this_grid();
    const int tid = threadIdx.x;
    unsigned char* ws = args.ws;
    volatile LAS unsigned* MISC = (volatile LAS unsigned*)(lds + LDS_MISC);
    if (tid < 64) ((LAS unsigned*)(lds + LDS_MISC))[tid] = 0u;
    __syncthreads();
    XcdBarrier bar = xcd_barrier_post((unsigned*)(ws + WS_CTL) + CW_BAR, MISC);
    const float* x = args.in[0]; float* out = args.out;
    bf16* R0 = (bf16*)(ws + WS_R0);
    bf16* R1 = (bf16*)(ws + WS_R1);
    constexpr size_t MD = (size_t)M * D;
    float* gtab = (float*)(ws + WS_GTAB); float* btab = (float*)(ws + WS_BTAB); float* elast = (float*)(ws + WS_ELAST);
    bf16* win = (bf16*)(ws + WS_WIN);
#define SEAM() xcd_barrier(bar)
#define GEMM_B(Ap, Btp, gM, gN, gK, ...) do { pg8::Gemm g{Ap, Btp, gM, gN, gK}; pg8::EpiB eb{__VA_ARGS__}; pg8::StaticOrder S; S.init(gM, gN, (int)gridDim.x, (int)blockIdx.x); \
        pg8::gemm_phase<pg8::EpiB, pg8::StaticOrder, true, true>(lds, g, S, eb); } while (0)
#define GEMM_F2(Ap, Btp, gM, gN, gK, ...) do { pg8::Gemm g{Ap, Btp, gM, gN, gK}; pg8::EpiF2 ef{__VA_ARGS__}; pg8::StaticOrder S; S.init(gM, gN, (int)gridDim.x, (int)blockIdx.x); \
        pg8::gemm_phase<pg8::EpiF2, pg8::StaticOrder, true, true>(lds, g, S, ef); } while (0)
#define GEMM_F(Ap, Btp, gM, gN, gK, ...) do { pg8::Gemm g{Ap, Btp, gM, gN, gK}; pg8::EpiF ef{__VA_ARGS__}; pg8::StaticOrder S; S.init(gM, gN, (int)gridDim.x, (int)blockIdx.x); \
        pg8::gemm_phase<pg8::EpiF, pg8::StaticOrder, true, true>(lds, g, S, ef); } while (0)
    phase_weights(lds, args.in[2], args.in[8], args.in[9], args.in[10], args.in[12], args.in[14], nullptr, ws, 2, (int)blockIdx.x, (int)gridDim.x); __syncthreads();
    phase_norm<1>(lds, x, args.in[1], R0, nullptr, args.in[2], args.in[5], args.in[6], gtab, btab);
    if (gridDim.y == 0x7fff) grid.sync();
    SEAM();
#ifdef DUP_P0
    phase_weights(lds, args.in[2], args.in[8], args.in[9], args.in[10], args.in[12], args.in[14], nullptr, ws, 2, (int)blockIdx.x, (int)gridDim.x); __syncthreads();
    phase_norm<1>(lds, x, args.in[1], R0, nullptr, args.in[2], args.in[5], args.in[6], gtab, btab);
    SEAM();
#endif
    GEMM_B(R0, win, M, 4096, D, R1, D, D, MD, 0, nullptr, nullptr);
    SEAM();
#ifdef DUP_P1
    GEMM_B(R0, win, M, 4096, D, R1, D, D, MD, 0, nullptr, nullptr);
    SEAM();
#endif
#if !defined(NO_G1) && !defined(DBG_NO_GDN)
    phase_g1(lds, R1, R1 + MD, R1 + 2 * MD, args.in[4], gtab, btab, elast, (u32x4*)R0, (u32x4*)out, (u32x4*)((bf16*)out + MD), (u32x4*)(ws + WS_AQ), (u32x2*)(ws + WS_U));
#endif
    SEAM();
#ifdef DUP_G1
    phase_g1(lds, R1, R1 + MD, R1 + 2 * MD, args.in[4], gtab, btab, elast, (u32x4*)R0, (u32x4*)out, (u32x4*)((bf16*)out + MD), (u32x4*)(ws + WS_AQ), (u32x2*)(ws + WS_U));
    SEAM();
#endif
#if !defined(NO_SCAN) && !defined(DBG_NO_GDN)
    phase_scan(lds, (const u32x4*)R0, (const u32x4*)((bf16*)out + MD), (const u32x2*)(ws + WS_U), elast, (u32x4*)R1, (u32x4*)(R1 + 2 * MD));
#endif
    SEAM();
#ifdef DUP_SCAN
    phase_scan(lds, (const u32x4*)R0, (const u32x4*)((bf16*)out + MD), (const u32x2*)(ws + WS_U), elast, (u32x4*)R1, (u32x4*)(R1 + 2 * MD));
    SEAM();
#endif
#ifdef DBG_NO_GDN
    for (size_t i = (size_t)blockIdx.x * 512 + tid; i < MD / 8; i += (size_t)gridDim.x * 512) ((u32x4*)out)[i] = (u32x4){0u, 0u, 0u, 0u};
#else
    phase_gout((const u32x4*)out, (const u32x4*)(ws + WS_AQ), (const u32x4*)R1, (const u32x4*)(R1 + 2 * MD), R1 + 3 * MD, args.in[7], (bf16*)out + MD);
#endif
    phase_norm<0>(lds, x, args.in[1], R0, nullptr, nullptr, nullptr, nullptr, nullptr, nullptr);
    SEAM();
    GEMM_B(R0, win + (size_t)4096 * D, M, 5120, D, R1, D, D, MD, 0, nullptr, nullptr);
    SEAM();
    phase_convA(R1, R1 + MD, R1 + 2 * MD, args.in[3], (bf16*)out);
    SEAM();
#ifdef DUP_EW
    phase_convA(R1, R1 + MD, R1 + 2 * MD, args.in[3], (bf16*)out);
    SEAM();
#endif
    GEMM_B((bf16*)out, (bf16*)(ws + WS_WA), M, D, D, R0, D, 0, 0, 1, R1 + 3 * MD, nullptr);
    SEAM();
    GEMM_B((bf16*)out + MD, (bf16*)(ws + WS_WB), M, D, D, R1, D, 0, 0, 2, R1 + 4 * MD, R0);
    SEAM();
    GEMM_F(R1, (bf16*)(ws + WS_WO), M, D, D, x, out, D);
    SEAM();
    phase_norm<0>(lds, out, args.in[11], R0, nullptr, nullptr, nullptr, nullptr, nullptr, nullptr);
    SEAM();
    {   pg8::StaticOrder SO; SO.init(65 * 256, 2 * FF, (int)gridDim.x, (int)blockIdx.x);
        for (int i = 0;; ++i) {
            pg8::Unit u; if (!SO.next(i, u)) break;
            pg8::Gemm g{R0 + ((long)254 * u.pm - 2) * D, (bf16*)(ws + WS_WUP), 256, 2 * FF, D};
            pg8::OneUnit s1{pg8::Unit{0, u.pn}};
            pg8::EpiAct ea{(bf16*)(ws + WS_ACT), args.in[13], nullptr, u.pm, u.pn, M, SEQ - 1, FF};
            pg8::gemm_phase<pg8::EpiAct, pg8::OneUnit, false, true>(lds, g, s1, ea);
        } }
    SEAM();
    GEMM_F((bf16*)(ws + WS_ACT), (bf16*)(ws + WS_WDN), M, D, FF, out, out, D);
    SEAM();
    phase_norm<2>(lds, out, args.in[15], nullptr, out, nullptr, nullptr, nullptr, nullptr, nullptr);
}

extern "C" void kernel_launch(void* const* d_in, const int* in_sizes, int n_in, void* d_out, int out_size, void* d_ws, size_t ws_size, hipStream_t stream) {
    static int grid = 0;
    if (grid == 0) {
        if (n_in != 16 || out_size != M * D || ws_size < WS_END) { fprintf(stderr, "kernel_launch: unexpected shapes (n_in %d out %d ws %zu)\n", n_in, out_size, ws_size); grid = -1; return; }
        int dev = 0, cus = 0, per_cu = 0;
        (void)hipGetDevice(&dev); (void)hipDeviceGetAttribute(&cus, hipDeviceAttributeMultiprocessorCount, dev);
        (void)hipFuncSetAttribute((const void*)fwd_megakernel, hipFuncAttributeMaxDynamicSharedMemorySize, LDS_BYTES);
        (void)hipOccupancyMaxActiveBlocksPerMultiprocessor(&per_cu, (const void*)fwd_megakernel, NWAVES * 64, LDS_BYTES);
        if (per_cu < 1) { fprintf(stderr, "kernel_launch: occupancy query says %d blocks per CU\n", per_cu); grid = -1; return; }
        grid = cus;
        if (grid < 64) { fprintf(stderr, "kernel_launch: needs >= 64 CUs\n"); grid = -1; return; }
    }
    if (grid < 0) return;
    (void)hipMemsetAsync((char*)d_ws + WS_CTL, 0, CTL_ZERO_BYTES, stream);
    Args a{};
    for (int i = 0; i < 16; ++i) a.in[i] = (const float*)d_in[i];
    a.out = (float*)d_out; a.ws = (unsigned char*)d_ws;
    void* params[] = {&a};
    hipError_t e = hipLaunchCooperativeKernel((const void*)fwd_megakernel, dim3(grid), dim3(NWAVES * 64), params, LDS_BYTES, stream);
    if (e != hipSuccess) fprintf(stderr, "kernel_launch: cooperative launch failed: %s (grid %d)\n", hipGetErrorString(e), grid);
}
```
